# Optimizing an MI355X kernel written in HIP

```python
import math
import jax, jax.numpy as jnp
from jax import lax
import numpy as np

D_MODEL = 1024
BATCH = 8
SEQ = 2048
DEPTH = 1
DEC_BATCH = 128
DEC_SEQ = 1
PAST_LEN = 2048
PAGE_SIZE = 128

H_RET = 4
DK_RET = D_MODEL // 8
DV_RET = D_MODEL // 8
RET_WIDTH = H_RET * DV_RET
H_DIFF = 4
DH_DIFF = D_MODEL // 16
DV_DIFF = 2 * DH_DIFF
DIFF_WIDTH = H_DIFF * DV_DIFF
MIX_WIDTH = RET_WIDTH + DIFF_WIDTH
IN_SPLITS = (H_RET * DK_RET, H_RET * DK_RET, H_RET * DV_RET, RET_WIDTH,
             H_DIFF * 2 * DH_DIFF, H_DIFF * 2 * DH_DIFF, H_DIFF * DV_DIFF)
IN_WIDTH = sum(IN_SPLITS)
D_FF = ((8 * D_MODEL // 3 + 127) // 128) * 128
CONV_W = 3
RET_CHUNK = 128
Q_BLOCK = 128
EPS = 1e-6
NEG_INF = -1e30

kernel_name = "hybrid_retention_diffattn_convffn_step"


def rms_norm(x, g):
    xf = x.astype(jnp.float32)
    y = xf * lax.rsqrt(jnp.mean(xf * xf, axis=-1, keepdims=True) + EPS)
    return (y * g.astype(jnp.float32)).astype(x.dtype)


def ret_log_decay():
    return jnp.log(1.0 - 2.0 ** (-5.0 - jnp.arange(H_RET, dtype=jnp.float32)))


def alibi_slopes(n):
    return 2.0 ** (-8.0 / n * jnp.arange(1, n + 1, dtype=jnp.float32))


def alibi_bias(qpos, kpos, slopes):
    dist = (qpos[:, None] - kpos[None, :]).astype(jnp.float32)
    return jnp.where(dist[None] >= 0, -slopes[:, None, None] * dist[None], NEG_INF)


def lambda_init(layer):
    return 0.8 - 0.6 * math.exp(-0.3 * layer)


def in_project(h, w_in):
    B, T = h.shape[0], h.shape[1]
    z = jnp.einsum('btd,de->bte', h, w_in)
    idx = [int(i) for i in np.cumsum(IN_SPLITS)[:-1]]
    rq, rk, rv, rg, dq, dk, dv = jnp.split(z, idx, axis=-1)
    f32 = jnp.float32
    rq = rq.reshape(B, T, H_RET, DK_RET).transpose(0, 2, 1, 3).astype(f32)
    rk = rk.reshape(B, T, H_RET, DK_RET).transpose(0, 2, 1, 3).astype(f32) * (DK_RET ** -0.5)
    rv = rv.reshape(B, T, H_RET, DV_RET).transpose(0, 2, 1, 3).astype(f32)
    dq = dq.reshape(B, T, H_DIFF, 2, DH_DIFF)
    dk = dk.reshape(B, T, H_DIFF, 2, DH_DIFF)
    dv = dv.reshape(B, T, H_DIFF, DV_DIFF)
    return rq, rk, rv, rg, dq, dk, dv


def retention_chunk(q, k, v, s, log_g):
    L = q.shape[2]
    i = jnp.arange(L, dtype=jnp.float32)
    diff = i[:, None] - i[None, :]
    causal = diff >= 0
    decay = jnp.where(causal[None], jnp.exp(jnp.where(causal, diff, 0.0)[None] * log_g[:, None, None]), 0.0)
    att = jnp.einsum('bhid,bhjd->bhij', q, k) * decay[None]
    q_dec = q * jnp.exp((i + 1.0)[None, :] * log_g[:, None])[None, :, :, None]
    o = jnp.einsum('bhij,bhje->bhie', att, v) + jnp.einsum('bhid,bhde->bhie', q_dec, s)
    k_dec = k * jnp.exp((L - 1.0 - i)[None, :] * log_g[:, None])[None, :, :, None]
    s_new = jnp.exp(L * log_g)[None, :, None, None] * s + jnp.einsum('bhjd,bhje->bhde', k_dec, v)
    return o, s_new


def retention_prompt(q, k, v, log_g):
    B, H, T, _ = q.shape
    nc = T // RET_CHUNK

    def to_chunks(a):
        return a.reshape(B, H, nc, RET_CHUNK, a.shape[-1]).transpose(2, 0, 1, 3, 4)

    def step(s, qkv):
        qc, kc, vc = qkv
        o, s = retention_chunk(qc, kc, vc, s, log_g)
        return s, o

    s0 = jnp.zeros((B, H, DK_RET, DV_RET), jnp.float32)
    s_fin, o = lax.scan(step, s0, (to_chunks(q), to_chunks(k), to_chunks(v)))
    o = o.transpose(1, 2, 0, 3, 4).reshape(B, H, T, DV_RET)
    return o, s_fin


def retention_out(o, g):
    B, T = g.shape[0], g.shape[1]
    o = o * lax.rsqrt(jnp.mean(o * o, axis=-1, keepdims=True) + EPS)
    o = o.transpose(0, 2, 1, 3).reshape(B, T, RET_WIDTH)
    return o.astype(g.dtype) * jax.nn.silu(g)


def diff_combine(p, lam):
    return p[:, :, 0] - lam * p[:, :, 1]


def diff_attn_prompt(dq, dk, dv, lam):
    B, T = dq.shape[0], dq.shape[1]
    nb = T // Q_BLOCK
    slopes = alibi_slopes(H_DIFF)
    kpos = jnp.arange(T)
    qb = dq.reshape(B, nb, Q_BLOCK, H_DIFF, 2, DH_DIFF).transpose(1, 0, 2, 3, 4, 5)

    def block(args):
        q, start = args
        qpos = start + jnp.arange(Q_BLOCK)
        s = jnp.einsum('bqhmd,bkhmd->bhmqk', q, dk).astype(jnp.float32) * (DH_DIFF ** -0.5)
        s = s + alibi_bias(qpos, kpos, slopes)[None, :, None]
        a = diff_combine(jax.nn.softmax(s, axis=-1), lam)
        return jnp.einsum('bhqk,bkhe->bqhe', a.astype(dv.dtype), dv)

    out = lax.map(block, (qb, jnp.arange(nb) * Q_BLOCK))
    return out.transpose(1, 0, 2, 3, 4).reshape(B, T, H_DIFF, DV_DIFF)


def diff_attn_sample(dq, dk, dv, k_past, v_past, lam):
    T = dq.shape[1]
    P = k_past.shape[1]
    slopes = alibi_slopes(H_DIFF)
    qpos = P + jnp.arange(T)
    scale = DH_DIFF ** -0.5
    s_past = jnp.einsum('bqhmd,bkhmd->bhmqk', dq, k_past).astype(jnp.float32) * scale
    s_new = jnp.einsum('bqhmd,bkhmd->bhmqk', dq, dk).astype(jnp.float32) * scale
    s_past = s_past + alibi_bias(qpos, jnp.arange(P), slopes)[None, :, None]
    s_new = s_new + alibi_bias(qpos, qpos, slopes)[None, :, None]
    p = jax.nn.softmax(jnp.concatenate([s_past, s_new], axis=-1), axis=-1)
    a = diff_combine(p, lam).astype(dv.dtype)
    return (jnp.einsum('bhqk,bkhe->bqhe', a[..., :P], v_past)
            + jnp.einsum('bhqk,bkhe->bqhe', a[..., P:], dv))


def mix_out(ret_o, rg, diff_o, subln_g, lam_i, w_o):
    B, T = rg.shape[0], rg.shape[1]
    a = retention_out(ret_o, rg)
    b = (rms_norm(diff_o, subln_g) * (1.0 - lam_i)).reshape(B, T, DIFF_WIDTH)
    m = jnp.concatenate([a, b.astype(a.dtype)], axis=-1)
    return jnp.einsum('bte,ed->btd', m, w_o)


def conv_ffn(h, buf, w_in, conv_w, conv_b, w_out):
    T = h.shape[1]
    z = jnp.einsum('btd,df->btf', h, w_in)
    g, u = jnp.split(z, [D_FF], axis=-1)
    xp = jnp.concatenate([buf.astype(g.dtype), g], axis=1)
    c = sum(conv_w[j] * xp[:, j:j + T] for j in range(CONV_W)) + conv_b
    y = jnp.einsum('btf,fd->btd', jax.nn.gelu(c) * u, w_out)
    return y, xp[:, -(CONV_W - 1):]


def setup_inputs(seed: int = 0) -> dict:
    key = jax.random.key(seed)
    ks = jax.random.split(key, 24)
    f32 = jnp.float32
    n_pages = PAST_LEN // PAGE_SIZE
    n_pool = (5 * DEC_BATCH * n_pages + 3) // 4
    nrm = lambda k, shape, s: jax.random.normal(k, shape, f32) * s
    perm = jax.random.permutation(ks[0], n_pool)[:DEC_BATCH * n_pages]
    return {
        'x_prompt': nrm(ks[1], (BATCH, SEQ, D_MODEL), 1.0),
        'x_sample': nrm(ks[2], (DEC_BATCH, DEC_SEQ, D_MODEL), 1.0),
        'state_ret': nrm(ks[3], (DEPTH, DEC_BATCH, H_RET, DK_RET, DV_RET), 0.5),
        'cache_k': nrm(ks[4], (DEPTH, n_pool, PAGE_SIZE, H_DIFF, 2, DH_DIFF), 1.0),
        'cache_v': nrm(ks[5], (DEPTH, n_pool, PAGE_SIZE, H_DIFF, DV_DIFF), 1.0),
        'state_conv': nrm(ks[6], (DEPTH, DEC_BATCH, CONV_W - 1, D_FF), 1.0),
        'page_table': perm.reshape(DEC_BATCH, n_pages).astype(jnp.int32),
        'norm_mix_pre': 1.0 + nrm(ks[7], (DEPTH, D_MODEL), 0.02),
        'norm_mix_post': 1.0 + nrm(ks[8], (DEPTH, D_MODEL), 0.02),
        'w_in': nrm(ks[9], (DEPTH, D_MODEL, IN_WIDTH), D_MODEL ** -0.5),
        'w_o': nrm(ks[10], (DEPTH, MIX_WIDTH, D_MODEL), MIX_WIDTH ** -0.5),
        'lambda_q1': nrm(ks[11], (DEPTH, DH_DIFF), 0.1),
        'lambda_k1': nrm(ks[12], (DEPTH, DH_DIFF), 0.1),
        'lambda_q2': nrm(ks[13], (DEPTH, DH_DIFF), 0.1),
        'lambda_k2': nrm(ks[14], (DEPTH, DH_DIFF), 0.1),
        'subln_g': 1.0 + nrm(ks[15], (DEPTH, DV_DIFF), 0.02),
        'norm_ffn_pre': 1.0 + nrm(ks[16], (DEPTH, D_MODEL), 0.02),
        'norm_ffn_post': 1.0 + nrm(ks[17], (DEPTH, D_MODEL), 0.02),
        'w_ffn_in': nrm(ks[18], (DEPTH, D_MODEL, 2 * D_FF), D_MODEL ** -0.5),
        'conv_w': nrm(ks[19], (DEPTH, CONV_W, D_FF), CONV_W ** -0.5),
        'conv_b': nrm(ks[20], (DEPTH, D_FF), 0.01),
        'w_ffn_out': nrm(ks[21], (DEPTH, D_FF, D_MODEL), D_FF ** -0.5),
    }


def reference(x_prompt, x_sample, state_ret, cache_k, cache_v, state_conv, page_table,
              norm_mix_pre, norm_mix_post, w_in, w_o, lambda_q1, lambda_k1, lambda_q2, lambda_k2,
              subln_g, norm_ffn_pre, norm_ffn_post, w_ffn_in, conv_w, conv_b, w_ffn_out):
    f32 = jnp.float32
    log_g = ret_log_decay()
    B = x_prompt.shape[0]
    DB = x_sample.shape[0]
    xp, xs = x_prompt, x_sample
    rsp, rss, kp, vp, kss, vss, cp, cs = [], [], [], [], [], [], [], []
    for l in range(DEPTH):
        lam_i = lambda_init(l)
        lam = (jnp.exp(jnp.sum(lambda_q1[l].astype(f32) * lambda_k1[l].astype(f32)))
               - jnp.exp(jnp.sum(lambda_q2[l].astype(f32) * lambda_k2[l].astype(f32))) + lam_i)

        h = rms_norm(xp, norm_mix_pre[l])
        rq, rk, rv, rg, dq, dk, dv = in_project(h, w_in[l])
        ro, s_fin = retention_prompt(rq, rk, rv, log_g)
        do = diff_attn_prompt(dq, dk, dv, lam)
        xp = xp + rms_norm(mix_out(ro, rg, do, subln_g[l], lam_i, w_o[l]), norm_mix_post[l])
        h = rms_norm(xp, norm_ffn_pre[l])
        f, cbuf = conv_ffn(h, jnp.zeros((B, CONV_W - 1, D_FF), h.dtype),
                           w_ffn_in[l], conv_w[l], conv_b[l], w_ffn_out[l])
        xp = xp + rms_norm(f, norm_ffn_post[l])
        rsp.append(s_fin.astype(x_prompt.dtype))
        kp.append(dk)
        vp.append(dv)
        cp.append(cbuf)

        h = rms_norm(xs, norm_mix_pre[l])
        rq, rk, rv, rg, dq, dk, dv = in_project(h, w_in[l])
        ro, s_new = retention_chunk(rq, rk, rv, state_ret[l].astype(f32), log_g)
        k_past = cache_k[l][page_table].reshape(DB, -1, H_DIFF, 2, DH_DIFF)
        v_past = cache_v[l][page_table].reshape(DB, -1, H_DIFF, DV_DIFF)
        do = diff_attn_sample(dq, dk, dv, k_past.astype(dq.dtype), v_past.astype(dv.dtype), lam)
        xs = xs + rms_norm(mix_out(ro, rg, do, subln_g[l], lam_i, w_o[l]), norm_mix_post[l])
        h = rms_norm(xs, norm_ffn_pre[l])
        f, cbuf = conv_ffn(h, state_conv[l], w_ffn_in[l], conv_w[l], conv_b[l], w_ffn_out[l])
        xs = xs + rms_norm(f, norm_ffn_post[l])
        rss.append(s_new.astype(state_ret.dtype))
        kss.append(dk)
        vss.append(dv)
        cs.append(cbuf)

    return (xp, xs, jnp.stack(rsp), jnp.stack(rss), jnp.stack(kp), jnp.stack(vp),
            jnp.stack(kss), jnp.stack(vss), jnp.stack(cp), jnp.stack(cs))
```

```cpp
#include <hip/hip_runtime.h>
#include <stdint.h>
#include <stdio.h>
namespace nv {
constexpr int D = 1024, B = 8, T = 2048, MP = B * T, DB = 128, M = MP + DB;
constexpr int NIN = 3584, DFF = 2816, NFF2 = 5632;
constexpr int PAST = 2048, PAGE = 128, NPAGES = 16;
constexpr float EPS = 1e-6f;
constexpr float RK_SCALE = 0.08838834764831845f;
constexpr size_t O_Y = 0, O_YS = O_Y + (size_t)MP * D, O_RSP = O_YS + (size_t)DB * D, O_RSS = O_RSP + (size_t)B * 4 * 128 * 128,
                 O_KP = O_RSS + (size_t)DB * 4 * 128 * 128, O_VP = O_KP + (size_t)MP * 512, O_KS = O_VP + (size_t)MP * 512, O_VS = O_KS + (size_t)DB * 512,
                 O_CP = O_VS + (size_t)DB * 512, O_CS = O_CP + (size_t)B * 2 * DFF, O_END = O_CS + (size_t)DB * 2 * DFF;
static_assert(O_END == 43495424, "output size");

__device__ __forceinline__ float wave_sum_f(float v) {
#pragma unroll
    for (int o = 1; o < 64; o <<= 1) v += __shfl_xor(v, o);
    return v;
}
__device__ __forceinline__ float wave_max_f(float v) {
#pragma unroll
    for (int o = 1; o < 64; o <<= 1) v = fmaxf(v, __shfl_xor(v, o));
    return v;
}
__device__ __forceinline__ float block_sum_f(float v, float* red) {
    v = wave_sum_f(v);
    __syncthreads();
    if ((threadIdx.x & 63) == 0) red[threadIdx.x >> 6] = v;
    __syncthreads();
    float s = 0.f;
    for (int i = 0; i < (int)(blockDim.x >> 6); ++i) s += red[i];
    return s;
}

__global__ void k_lambda(const float* q1, const float* k1, const float* q2, const float* k2, float* lam) {
    const int l = threadIdx.x;
    const float a = wave_sum_f(q1[l] * k1[l]), b = wave_sum_f(q2[l] * k2[l]);
    if (l == 0) lam[0] = expf(a) - expf(b) + 0.2f;
}

__global__ __launch_bounds__(256) void k_rmsnorm_in(const float* xp, const float* xs, const float* g, float* out) {
    __shared__ float red[8];
    const int r = blockIdx.x;
    const float* x = r < MP ? xp + (size_t)r * D : xs + (size_t)(r - MP) * D;
    const float4 v = ((const float4*)x)[threadIdx.x];
    const float s = block_sum_f(v.x * v.x + v.y * v.y + v.z * v.z + v.w * v.w, red);
    const float rs = rsqrtf(s * (1.f / D) + EPS);
    const float4 gg = ((const float4*)g)[threadIdx.x];
    float4 o; o.x = v.x * rs * gg.x; o.y = v.y * rs * gg.y; o.z = v.z * rs * gg.z; o.w = v.w * rs * gg.w;
    ((float4*)(out + (size_t)r * D))[threadIdx.x] = o;
}

__global__ __launch_bounds__(256) void k_sgemm(const float* __restrict__ A, const float* __restrict__ Bm, float* __restrict__ C, int Mr, int N, int K) {
    __shared__ float As[16][68];
    __shared__ float Bs[16][64];
    const int tid = threadIdx.x, tx = tid & 15, ty = tid >> 4;
    const int m0 = blockIdx.y * 64, n0 = blockIdx.x * 64;
    float acc[4][4];
#pragma unroll
    for (int i = 0; i < 4; ++i)
#pragma unroll
        for (int j = 0; j < 4; ++j) acc[i][j] = 0.f;
    for (int k0 = 0; k0 < K; k0 += 16) {
        const float4 a = *(const float4*)(A + (size_t)(m0 + (tid >> 2)) * K + k0 + (tid & 3) * 4);
        const float4 b = *(const float4*)(Bm + (size_t)(k0 + (tid >> 4)) * N + n0 + (tid & 15) * 4);
        As[(tid & 3) * 4 + 0][tid >> 2] = a.x; As[(tid & 3) * 4 + 1][tid >> 2] = a.y; As[(tid & 3) * 4 + 2][tid >> 2] = a.z; As[(tid & 3) * 4 + 3][tid >> 2] = a.w;
        *(float4*)&Bs[tid >> 4][(tid & 15) * 4] = b;
        __syncthreads();
#pragma unroll
        for (int k = 0; k < 16; ++k) {
            const float4 av = *(const float4*)&As[k][ty * 4];
            const float4 bv = *(const float4*)&Bs[k][tx * 4];
            const float aa[4] = {av.x, av.y, av.z, av.w}, bb[4] = {bv.x, bv.y, bv.z, bv.w};
#pragma unroll
            for (int i = 0; i < 4; ++i)
#pragma unroll
                for (int j = 0; j < 4; ++j) acc[i][j] += aa[i] * bb[j];
        }
        __syncthreads();
    }
#pragma unroll
    for (int i = 0; i < 4; ++i) {
        float4 o; o.x = acc[i][0]; o.y = acc[i][1]; o.z = acc[i][2]; o.w = acc[i][3];
        *(float4*)(C + (size_t)(m0 + ty * 4 + i) * N + n0 + tx * 4) = o;
    }
}

__global__ void k_kvrows(const float* Z, float* out) {
    const int r = blockIdx.x, c = threadIdx.x;
    const float4 v = *(const float4*)(Z + (size_t)r * NIN + 2560 + c * 4);
    const int col = c * 4;
    float* dst;
    if (r < MP) dst = (col < 512) ? out + O_KP + (size_t)r * 512 + col : out + O_VP + (size_t)r * 512 + (col - 512);
    else        dst = (col < 512) ? out + O_KS + (size_t)(r - MP) * 512 + col : out + O_VS + (size_t)(r - MP) * 512 + (col - 512);
    *(float4*)dst = v;
}

__global__ __launch_bounds__(256) void k_ret_prompt(const float* Z, float* RO, float* out) {
    const int bh = blockIdx.x, b = bh >> 2, h = bh & 3, e0 = blockIdx.y * 32;
    const int tid = threadIdx.x, e = tid & 31, dg = tid >> 5;
    const float gamma = 1.f - exp2f(-5.f - (float)h);
    __shared__ float qs[128], ks[128], red[8][32];
    float S[16];
#pragma unroll
    for (int i = 0; i < 16; ++i) S[i] = 0.f;
    for (int t = 0; t < T; ++t) {
        const float* z = Z + (size_t)(b * T + t) * NIN;
        if (tid < 128) qs[tid] = z[h * 128 + tid]; else ks[tid - 128] = z[512 + h * 128 + (tid - 128)] * RK_SCALE;
        const float v = z[1024 + h * 128 + e0 + e];
        __syncthreads();
        float o = 0.f;
#pragma unroll
        for (int i = 0; i < 16; ++i) { const int d = dg * 16 + i; S[i] = gamma * S[i] + ks[d] * v; o += qs[d] * S[i]; }
        red[dg][e] = o;
        __syncthreads();
        if (tid < 32) { float s = 0.f;
#pragma unroll
            for (int j = 0; j < 8; ++j) s += red[j][tid];
            RO[(size_t)(b * T + t) * 512 + h * 128 + e0 + tid] = s; }
    }
#pragma unroll
    for (int i = 0; i < 16; ++i) out[O_RSP + ((size_t)(bh * 128 + dg * 16 + i)) * 128 + e0 + e] = S[i];
}

__global__ __launch_bounds__(256) void k_ret_sample(const float* Z, const float* state, float* RO, float* out) {
    const int bh = blockIdx.x, b = bh >> 2, h = bh & 3;
    const int tid = threadIdx.x, e = tid & 127, dh = tid >> 7;
    const float gamma = 1.f - exp2f(-5.f - (float)h);
    __shared__ float qs[128], ks[128], red[128];
    const float* z = Z + (size_t)(MP + b) * NIN;
    if (tid < 128) qs[tid] = z[h * 128 + tid]; else ks[tid - 128] = z[512 + h * 128 + (tid - 128)] * RK_SCALE;
    const float v = z[1024 + h * 128 + e];
    __syncthreads();
    float o = 0.f;
    for (int i = 0; i < 64; ++i) { const int d = dh * 64 + i; const size_t idx = ((size_t)bh * 128 + d) * 128 + e;
        const float s = gamma * state[idx] + ks[d] * v; out[O_RSS + idx] = s; o += qs[d] * s; }
    if (dh == 1) red[e] = o;
    __syncthreads();
    if (dh == 0) RO[(size_t)(MP + b) * 512 + h * 128 + e] = o + red[e];
}

__global__ __launch_bounds__(256) void k_diff_prompt(const float* Z, const float* lamp, float* DO) {
    __shared__ float qsm[4][128];
    const int wid = threadIdx.x >> 6, lane = threadIdx.x & 63;
    const int idx = blockIdx.x * 4 + wid, t = idx % T, h = (idx / T) & 3, b = idx / (4 * T);
    const float lam = lamp[0];
    const float slope = exp2f(-2.f * (float)(h + 1));
    const float* zq = Z + (size_t)(b * T + t) * NIN + 2048 + h * 128;
    qsm[wid][lane] = zq[lane]; qsm[wid][64 + lane] = zq[64 + lane];
    __syncthreads();
    const float* qs = qsm[wid];
    float m0 = -1e30f, l0 = 0.f, m1 = -1e30f, l1 = 0.f;
    for (int kc = 0; kc <= t; kc += 64) {
        const int key = kc + lane;
        if (key <= t) {
            const float* kr = Z + (size_t)(b * T + key) * NIN + 2560 + h * 128;
            float s0 = 0.f, s1 = 0.f;
            for (int d = 0; d < 64; d += 4) { const float4 a = *(const float4*)(kr + d), c = *(const float4*)(kr + 64 + d);
                s0 += qs[d] * a.x + qs[d + 1] * a.y + qs[d + 2] * a.z + qs[d + 3] * a.w;
                s1 += qs[64 + d] * c.x + qs[65 + d] * c.y + qs[66 + d] * c.z + qs[67 + d] * c.w; }
            const float bias = -slope * (float)(t - key);
            s0 = s0 * 0.125f + bias; s1 = s1 * 0.125f + bias;
            float mn = fmaxf(m0, s0); l0 = l0 * expf(m0 - mn) + expf(s0 - mn); m0 = mn;
            mn = fmaxf(m1, s1); l1 = l1 * expf(m1 - mn) + expf(s1 - mn); m1 = mn;
        }
    }
    const float M0 = wave_max_f(m0), M1 = wave_max_f(m1);
    const float L0 = wave_sum_f(l0 * expf(m0 - M0)), L1 = wave_sum_f(l1 * expf(m1 - M1));
    const float i0 = 1.f / L0, i1 = 1.f / L1;
    float acc0 = 0.f, acc1 = 0.f;
    for (int kc = 0; kc <= t; kc += 64) {
        const int key = kc + lane;
        float a = 0.f;
        if (key <= t) {
            const float* kr = Z + (size_t)(b * T + key) * NIN + 2560 + h * 128;
            float s0 = 0.f, s1 = 0.f;
            for (int d = 0; d < 64; d += 4) { const float4 x = *(const float4*)(kr + d), c = *(const float4*)(kr + 64 + d);
                s0 += qs[d] * x.x + qs[d + 1] * x.y + qs[d + 2] * x.z + qs[d + 3] * x.w;
                s1 += qs[64 + d] * c.x + qs[65 + d] * c.y + qs[66 + d] * c.z + qs[67 + d] * c.w; }
            const float bias = -slope * (float)(t - key);
            s0 = s0 * 0.125f + bias; s1 = s1 * 0.125f + bias;
            a = expf(s0 - M0) * i0 - lam * expf(s1 - M1) * i1;
        }
        const int nk = min(64, t + 1 - kc);
        for (int j = 0; j < nk; ++j) {
            const float aj = __shfl(a, j);
            const float2 v = *(const float2*)(Z + (size_t)(b * T + kc + j) * NIN + 3072 + h * 128 + lane * 2);
            acc0 += aj * v.x; acc1 += aj * v.y;
        }
    }
    float2 o; o.x = acc0; o.y = acc1;
    *(float2*)(DO + (size_t)(b * T + t) * 512 + h * 128 + lane * 2) = o;
}

__global__ __launch_bounds__(64) void k_diff_sample(const float* Z, const float* ck, const float* cv, const int* pt, const float* lamp, float* DO) {
    __shared__ float qs[128];
    const int lane = threadIdx.x, b = blockIdx.x >> 2, h = blockIdx.x & 3;
    const float lam = lamp[0];
    const float slope = exp2f(-2.f * (float)(h + 1));
    const float* zr = Z + (size_t)(MP + b) * NIN;
    qs[lane] = zr[2048 + h * 128 + lane]; qs[64 + lane] = zr[2048 + h * 128 + 64 + lane];
    __syncthreads();
    float m0 = -1e30f, l0 = 0.f, m1 = -1e30f, l1 = 0.f;
    for (int kc = 0; kc <= PAST; kc += 64) {
        const int key = kc + lane;
        if (key <= PAST) {
            const float* kr = key < PAST ? ck + ((size_t)pt[b * NPAGES + (key >> 7)] * PAGE + (key & 127)) * 512 + h * 128 : zr + 2560 + h * 128;
            float s0 = 0.f, s1 = 0.f;
            for (int d = 0; d < 64; d += 4) { const float4 a = *(const float4*)(kr + d), c = *(const float4*)(kr + 64 + d);
                s0 += qs[d] * a.x + qs[d + 1] * a.y + qs[d + 2] * a.z + qs[d + 3] * a.w;
                s1 += qs[64 + d] * c.x + qs[65 + d] * c.y + qs[66 + d] * c.z + qs[67 + d] * c.w; }
            const float bias = -slope * (float)(PAST - key);
            s0 = s0 * 0.125f + bias; s1 = s1 * 0.125f + bias;
            float mn = fmaxf(m0, s0); l0 = l0 * expf(m0 - mn) + expf(s0 - mn); m0 = mn;
            mn = fmaxf(m1, s1); l1 = l1 * expf(m1 - mn) + expf(s1 - mn); m1 = mn;
        }
    }
    const float M0 = wave_max_f(m0), M1 = wave_max_f(m1);
    const float L0 = wave_sum_f(l0 * expf(m0 - M0)), L1 = wave_sum_f(l1 * expf(m1 - M1));
    const float i0 = 1.f / L0, i1 = 1.f / L1;
    float acc0 = 0.f, acc1 = 0.f;
    for (int kc = 0; kc <= PAST; kc += 64) {
        const int key = kc + lane;
        float a = 0.f;
        if (key <= PAST) {
            const float* kr = key < PAST ? ck + ((size_t)pt[b * NPAGES + (key >> 7)] * PAGE + (key & 127)) * 512 + h * 128 : zr + 2560 + h * 128;
            float s0 = 0.f, s1 = 0.f;
            for (int d = 0; d < 64; d += 4) { const float4 x = *(const float4*)(kr + d), c = *(const float4*)(kr + 64 + d);
                s0 += qs[d] * x.x + qs[d + 1] * x.y + qs[d + 2] * x.z + qs[d + 3] * x.w;
                s1 += qs[64 + d] * c.x + qs[65 + d] * c.y + qs[66 + d] * c.z + qs[67 + d] * c.w; }
            const float bias = -slope * (float)(PAST - key);
            s0 = s0 * 0.125f + bias; s1 = s1 * 0.125f + bias;
            a = expf(s0 - M0) * i0 - lam * expf(s1 - M1) * i1;
        }
        const int nk = min(64, PAST + 1 - kc);
        for (int j = 0; j < nk; ++j) {
            const float aj = __shfl(a, j);
            const int kj = kc + j;
            const float* vr = kj < PAST ? cv + ((size_t)pt[b * NPAGES + (kj >> 7)] * PAGE + (kj & 127)) * 512 + h * 128 : zr + 3072 + h * 128;
            const float2 v = *(const float2*)(vr + lane * 2);
            acc0 += aj * v.x; acc1 += aj * v.y;
        }
    }
    float2 o; o.x = acc0; o.y = acc1;
    *(float2*)(DO + (size_t)(MP + b) * 512 + h * 128 + lane * 2) = o;
}

__global__ __launch_bounds__(128) void k_mix(const float* Z, const float* RO, const float* DO, const float* subg, float* MIX) {
    __shared__ float red[8];
    const int r = blockIdx.x, e = threadIdx.x;
    for (int h = 0; h < 4; ++h) {
        const float o = RO[(size_t)r * 512 + h * 128 + e];
        const float s = block_sum_f(o * o, red);
        const float g = Z[(size_t)r * NIN + 1536 + h * 128 + e];
        MIX[(size_t)r * D + h * 128 + e] = o * rsqrtf(s * (1.f / 128.f) + EPS) * (g / (1.f + expf(-g)));
        const float d = DO[(size_t)r * 512 + h * 128 + e];
        const float s2 = block_sum_f(d * d, red);
        MIX[(size_t)r * D + 512 + h * 128 + e] = d * rsqrtf(s2 * (1.f / 128.f) + EPS) * subg[e] * 0.8f;
    }
}

__global__ __launch_bounds__(256) void k_post1(const float* xp, const float* xs, const float* T1, const float* gpost, const float* gpre2, float* X1, float* H2) {
    __shared__ float red[8];
    const int r = blockIdx.x;
    const float* x = r < MP ? xp + (size_t)r * D : xs + (size_t)(r - MP) * D;
    const float4 xv = ((const float4*)x)[threadIdx.x];
    const float4 tv = ((const float4*)(T1 + (size_t)r * D))[threadIdx.x];
    const float s = block_sum_f(tv.x * tv.x + tv.y * tv.y + tv.z * tv.z + tv.w * tv.w, red);
    const float rs = rsqrtf(s * (1.f / D) + EPS);
    const float4 g1 = ((const float4*)gpost)[threadIdx.x];
    float4 x1; x1.x = xv.x + tv.x * rs * g1.x; x1.y = xv.y + tv.y * rs * g1.y; x1.z = xv.z + tv.z * rs * g1.z; x1.w = xv.w + tv.w * rs * g1.w;
    ((float4*)(X1 + (size_t)r * D))[threadIdx.x] = x1;
    const float s2 = block_sum_f(x1.x * x1.x + x1.y * x1.y + x1.z * x1.z + x1.w * x1.w, red);
    const float rs2 = rsqrtf(s2 * (1.f / D) + EPS);
    const float4 g2 = ((const float4*)gpre2)[threadIdx.x];
    float4 h2; h2.x = x1.x * rs2 * g2.x; h2.y = x1.y * rs2 * g2.y; h2.z = x1.z * rs2 * g2.z; h2.w = x1.w * rs2 * g2.w;
    ((float4*)(H2 + (size_t)r * D))[threadIdx.x] = h2;
}

__device__ __forceinline__ float gelu_tanh_f(float c) { return 0.5f * c * (1.f + tanhf(0.7978845608028654f * (c + 0.044715f * c * c * c))); }

__global__ __launch_bounds__(256) void k_act(const float* Z2, const float* sconv, const float* cw, const float* cb, float* ACT, float* out) {
    const int r = blockIdx.x, f = blockIdx.y * 256 + threadIdx.x;
    const float g = Z2[(size_t)r * NFF2 + f], u = Z2[(size_t)r * NFF2 + DFF + f];
    float g1, g2;
    if (r < MP) { const int t = r % T, b = r / T;
        g1 = t >= 1 ? Z2[(size_t)(r - 1) * NFF2 + f] : 0.f; g2 = t >= 2 ? Z2[(size_t)(r - 2) * NFF2 + f] : 0.f;
        if (t >= T - 2) out[O_CP + ((size_t)b * 2 + (t - (T - 2))) * DFF + f] = g;
    } else { const int bi = r - MP;
        g1 = sconv[((size_t)bi * 2 + 1) * DFF + f]; g2 = sconv[((size_t)bi * 2 + 0) * DFF + f];
        out[O_CS + ((size_t)bi * 2 + 0) * DFF + f] = g1; out[O_CS + ((size_t)bi * 2 + 1) * DFF + f] = g;
    }
    const float c = cw[f] * g2 + cw[DFF + f] * g1 + cw[2 * DFF + f] * g + cb[f];
    ACT[(size_t)r * DFF + f] = gelu_tanh_f(c) * u;
}

__global__ __launch_bounds__(256) void k_final(const float* X1, const float* T2, const float* g, float* out) {
    __shared__ float red[8];
    const int r = blockIdx.x;
    const float4 xv = ((const float4*)(X1 + (size_t)r * D))[threadIdx.x];
    const float4 tv = ((const float4*)(T2 + (size_t)r * D))[threadIdx.x];
    const float s = block_sum_f(tv.x * tv.x + tv.y * tv.y + tv.z * tv.z + tv.w * tv.w, red);
    const float rs = rsqrtf(s * (1.f / D) + EPS);
    const float4 gg = ((const float4*)g)[threadIdx.x];
    float4 y; y.x = xv.x + tv.x * rs * gg.x; y.y = xv.y + tv.y * rs * gg.y; y.z = xv.z + tv.z * rs * gg.z; y.w = xv.w + tv.w * rs * gg.w;
    float* dst = r < MP ? out + O_Y + (size_t)r * D : out + O_YS + (size_t)(r - MP) * D;
    ((float4*)dst)[threadIdx.x] = y;
}

struct Ws {
    float *HN, *Z, *RO, *DO, *MIX, *T1, *X1, *H2, *Z2, *ACT, *T2, *LAM;
};
constexpr size_t WS_FLOATS = (size_t)M * (D + NIN + 512 + 512 + D + D + D + D + NFF2 + DFF + D) + 64;
inline Ws carve(float* base) {
    Ws w; float* p = base;
    w.LAM = p; p += 64;
    w.HN = p; p += (size_t)M * D; w.Z = p; p += (size_t)M * NIN; w.RO = p; p += (size_t)M * 512; w.DO = p; p += (size_t)M * 512;
    w.MIX = p; p += (size_t)M * D; w.T1 = p; p += (size_t)M * D; w.X1 = p; p += (size_t)M * D; w.H2 = p; p += (size_t)M * D;
    w.Z2 = p; p += (size_t)M * NFF2; w.ACT = p; p += (size_t)M * DFF; w.T2 = p; p += (size_t)M * D;
    return w;
}

inline void run(void* const* d_in, float* out, float* wsbase, hipStream_t st) {
    const float* xp = (const float*)d_in[0]; const float* xs = (const float*)d_in[1]; const float* sret = (const float*)d_in[2];
    const float* ck = (const float*)d_in[3]; const float* cv = (const float*)d_in[4]; const float* sconv = (const float*)d_in[5];
    const int* pt = (const int*)d_in[6];
    const float* g_pre = (const float*)d_in[7]; const float* g_post = (const float*)d_in[8];
    const float* w_in = (const float*)d_in[9]; const float* w_o = (const float*)d_in[10];
    const float* g_sub = (const float*)d_in[15]; const float* g_fpre = (const float*)d_in[16]; const float* g_fpost = (const float*)d_in[17];
    const float* w_f1 = (const float*)d_in[18]; const float* cw = (const float*)d_in[19]; const float* cb = (const float*)d_in[20]; const float* w_f2 = (const float*)d_in[21];
    Ws w = carve(wsbase);
    k_lambda<<<1, 64, 0, st>>>((const float*)d_in[11], (const float*)d_in[12], (const float*)d_in[13], (const float*)d_in[14], w.LAM);
    k_rmsnorm_in<<<M, 256, 0, st>>>(xp, xs, g_pre, w.HN);
    k_sgemm<<<dim3(NIN / 64, M / 64), 256, 0, st>>>(w.HN, w_in, w.Z, M, NIN, D);
    k_kvrows<<<M, 256, 0, st>>>(w.Z, out);
    k_ret_prompt<<<dim3(32, 4), 256, 0, st>>>(w.Z, w.RO, out);
    k_ret_sample<<<512, 256, 0, st>>>(w.Z, sret, w.RO, out);
    k_diff_prompt<<<MP * 4 / 4, 256, 0, st>>>(w.Z, w.LAM, w.DO);
    k_diff_sample<<<DB * 4, 64, 0, st>>>(w.Z, ck, cv, pt, w.LAM, w.DO);
    k_mix<<<M, 128, 0, st>>>(w.Z, w.RO, w.DO, g_sub, w.MIX);
    k_sgemm<<<dim3(D / 64, M / 64), 256, 0, st>>>(w.MIX, w_o, w.T1, M, D, D);
    k_post1<<<M, 256, 0, st>>>(xp, xs, w.T1, g_post, g_fpre, w.X1, w.H2);
    k_sgemm<<<dim3(NFF2 / 64, M / 64), 256, 0, st>>>(w.H2, w_f1, w.Z2, M, NFF2, D);
    k_act<<<dim3(M, DFF / 256), 256, 0, st>>>(w.Z2, sconv, cw, cb, w.ACT, out);
    k_sgemm<<<dim3(D / 64, M / 64), 256, 0, st>>>(w.ACT, w_f2, w.T2, M, D, DFF);
    k_final<<<M, 256, 0, st>>>(w.X1, w.T2, g_fpost, out);
}
}
extern "C" void kernel_launch(void* const* d_in, const int* in_sizes, int n_in, void* d_out, int out_size, void* d_ws, size_t ws_size, hipStream_t stream) {
    if (n_in != 22 || out_size != (int)nv::O_END || ws_size < nv::WS_FLOATS * 4) { fprintf(stderr, "kernel_launch: unexpected sizes n_in %d out %d ws %zu\n", n_in, out_size, ws_size); return; }
    nv::run(d_in, (float*)d_out, (float*)d_ws, stream);
}
```

```cpp
#include <hip/hip_runtime.h>
#include <hip/hip_bf16.h>
#include <cstdio>
#include <cstdint>
#include <cmath>
namespace pg8 {
#define PG8_LAS __attribute__((address_space(3)))
typedef unsigned short bf16_t;
typedef short bf16x8 __attribute__((ext_vector_type(8)));
typedef float f32x4 __attribute__((ext_vector_type(4)));
typedef unsigned u32x4 __attribute__((ext_vector_type(4)));
constexpr int BM = 256, BK = 64, HALF = 128, HTB = HALF * BK * 2  , STAGE_BYTES = 8 * HTB, NXCD = 8, WGM = 8;

__host__ __device__ __forceinline__ int lds_byte(int r, int c) { const int st = (r >> 4) * 2 + (c >> 5), rr = r & 15, cc = c & 31, ob = rr * 64 + cc * 2; return st * 1024 + (ob ^ (((ob >> 9) & 1) << 5)); }
__host__ __device__ __forceinline__ void stage_rc(int b, int& R, int& C) { const int st = b / 1024, sb = b % 1024, swz = sb ^ (((sb >> 9) & 1) << 5); R = (st >> 1) * 16 + swz / 64; C = (st & 1) * 32 + (swz % 64) / 2; }
__host__ __device__ __forceinline__ int perm32(int rho) { const int n = rho >> 4, i = rho & 15; return 8 * (i >> 2) + 4 * n + (i & 3); }

struct Unit { int pm, pn; };
struct Gemm { const bf16_t* A; const bf16_t* Bt; int M, N, K; };

struct StaticOrder {
    int nM, nN, nwg, G, c;
    __host__ __device__ void init(int M, int N, int G_, int c_) { nM = M / BM; nN = N / BM; nwg = nM * nN; G = G_; c = c_; }
    __host__ __device__ bool next(int i, Unit& u) const {
        const long L = (long)i * G + c; if (L >= nwg) return false;
        int wgid = (int)L; { const int q = nwg / NXCD, r = nwg % NXCD, xcd = wgid % NXCD, off = wgid / NXCD; wgid = (xcd < r ? xcd * (q + 1) : r * (q + 1) + (xcd - r) * q) + off; }
        const int nig = WGM * nN, gid = wgid / nig, fm = gid * WGM, gsz = (nM - fm) < WGM ? (nM - fm) : WGM;
        u.pm = fm + ((wgid % nig) % gsz); u.pn = (wgid % nig) / gsz; return true;
    }
    __device__ __forceinline__ void a_ready(const Unit&) const {}
    __device__ __forceinline__ void done(const Unit&) const {}
};

__device__ __forceinline__ unsigned cvt_pk_bf16(float lo, float hi) { unsigned r; asm volatile("v_cvt_pk_bf16_f32 %0, %1, %2" : "=v"(r) : "v"(lo), "v"(hi)); return r; }
typedef float f32x2 __attribute__((ext_vector_type(2)));
__device__ __forceinline__ f32x2 gelu_pk(f32x2 v) {
    const f32x2 av = __builtin_elementwise_abs(v), d = av * 0.2316418882f + 1.0f;
    f32x2 t; t.x = __builtin_amdgcn_rcpf(d.x); t.y = __builtin_amdgcn_rcpf(d.y);
    f32x2 q = t * 0.5307027145f + (-0.7265760135f); q = q * t + 0.7107068705f; q = q * t + (-0.142248368f); q = q * t + 0.127414796f; q = q * t;
    const f32x2 s = (v * v) * (-0.72134752044f);
    f32x2 e; e.x = __builtin_amdgcn_exp2f(s.x); e.y = __builtin_amdgcn_exp2f(s.y);
    const f32x2 m = v * (q * e), r = v - m;
    f32x2 o; o.x = v.x < 0.f ? m.x : r.x; o.y = v.y < 0.f ? m.y : r.y; return o;
}

template <int ACT  > struct EpiBf16 {
    static constexpr bool PERM = true, AFTER_DRAIN = false; static_assert(ACT == 0 || ACT == 1, "EpiBf16: ACT is 0 (none) or 1 (gelu_pk)");
    bf16_t* O; int ldc; const float* bias; int split_cols; size_t split_stride; float scale0;
    __device__ __forceinline__ void operator()(const f32x4 (&acc)[2][2][4][2], const Unit& u, int wr, int wc, int fr, int fq) const {
        const int row0 = u.pm * BM + wr * 64 + fr; int colt = u.pn * BM; bf16_t* base = O;
        float sc = 1.f; if (split_cols) { const int t = colt / split_cols; base += (size_t)t * split_stride; colt -= t * split_cols; if (t == 0) sc = scale0; }
        const int col0 = colt + wc * 32 + 8 * fq, bcol0 = u.pn * BM + wc * 32 + 8 * fq;
        f32x4 bv[2][2];
#pragma unroll
        for (int bj = 0; bj < 2; ++bj)
#pragma unroll
            for (int n = 0; n < 2; ++n) bv[bj][n] = bias ? *(const f32x4*)(bias + bcol0 + bj * HALF + 4 * n) : (f32x4){0.f, 0.f, 0.f, 0.f};
#pragma unroll
        for (int ai = 0; ai < 2; ++ai)
#pragma unroll
            for (int m = 0; m < 4; ++m) { bf16_t* rowp = base + (size_t)(row0 + ai * HALF + m * 16) * ldc + col0;
#pragma unroll
                for (int bj = 0; bj < 2; ++bj) { f32x4 v0 = acc[ai][bj][m][0] + bv[bj][0], v1 = acc[ai][bj][m][1] + bv[bj][1];
                    if (ACT == 1) { f32x2 a = gelu_pk((f32x2){v0[0], v0[1]}), b = gelu_pk((f32x2){v0[2], v0[3]}), c = gelu_pk((f32x2){v1[0], v1[1]}), d = gelu_pk((f32x2){v1[2], v1[3]});
                        v0 = (f32x4){a.x, a.y, b.x, b.y}; v1 = (f32x4){c.x, c.y, d.x, d.y}; }
                    v0 = v0 * sc; v1 = v1 * sc; u32x4 w; w.x = cvt_pk_bf16(v0[0], v0[1]); w.y = cvt_pk_bf16(v0[2], v0[3]); w.z = cvt_pk_bf16(v1[0], v1[1]); w.w = cvt_pk_bf16(v1[2], v1[3]);
                    *(u32x4*)(rowp + bj * HALF) = w; } }
    }
};
template <class Epi, class Sched, bool ALIGN_EPI = false, bool SP2 = false>
__device__ __forceinline__ void gemm_phase(PG8_LAS unsigned char* lds, const Gemm g, const Sched& S, const Epi& E) {
    const int tid = threadIdx.x, wid = __builtin_amdgcn_readfirstlane(tid >> 6), lane = tid & 63, wr = wid >> 2, wc = wid & 3, fr = lane & 15, fq = lane >> 4;
    const int K = g.K, nt = K / BK;
    unsigned voffA[2], voffB[2];
#pragma unroll
    for (int i = 0; i < 2; ++i) { int R, C; stage_rc(tid * 16 + i * 8192, R, C); const int Rb = Epi::PERM ? ((R & ~31) + perm32(R & 31)) : R;
        voffA[i] = (unsigned)(R * K + C) * 2u; voffB[i] = (unsigned)(Rb * K + C) * 2u; }
    const size_t kstep = (size_t)(BK * 2);
    const size_t hstep = (size_t)HALF * K * 2;
    const size_t tstep = 2 * hstep;
    const unsigned ldsw = (unsigned)wid * 1024u;
    const int aoff = lds_byte(wr * 64 + fr, fq * 8), boff = lds_byte(wc * 32 + fr, fq * 8);
#define PG8_SA(b, h) (((b) * 2 + (h)) * HTB)
#define PG8_SB(b, h) ((4 + (b) * 2 + (h)) * HTB)
#define PG8_STAGE(bufoff, gbase, voff) do { _Pragma("unroll") for (int _i = 0; _i < 2; ++_i) \
        __builtin_amdgcn_global_load_lds((const unsigned*)((const char*)(gbase) + (voff)[_i]), (PG8_LAS unsigned*)(lds + (bufoff) + ldsw + _i * 8192), 16, 0, 0); } while (0)
#define PG8_LDA(dst, b, h) do { _Pragma("unroll") for (int m = 0; m < 4; ++m) _Pragma("unroll") for (int k = 0; k < 2; ++k) dst[m][k] = *(const PG8_LAS bf16x8*)(lds + PG8_SA(b, h) + aoff + m * 2048 + k * 1024); } while (0)
#define PG8_LDB(dst, b, h) do { _Pragma("unroll") for (int n = 0; n < 2; ++n) _Pragma("unroll") for (int k = 0; k < 2; ++k) dst[n][k] = *(const PG8_LAS bf16x8*)(lds + PG8_SB(b, h) + boff + n * 2048 + k * 1024); } while (0)
#define PG8_MMA(ai, bj, At, Bt) do { __builtin_amdgcn_s_setprio(1); _Pragma("unroll") for (int m = 0; m < 4; ++m) _Pragma("unroll") for (int n = 0; n < 2; ++n) _Pragma("unroll") for (int k = 0; k < 2; ++k) \
        acc[ai][bj][m][n] = __builtin_amdgcn_mfma_f32_16x16x32_bf16(Bt[n][k], At[m][k], acc[ai][bj][m][n], 0, 0, 0); __builtin_amdgcn_s_setprio(0); } while (0)
#define PG8_WAIT_V(n) asm volatile("s_waitcnt vmcnt(" #n ")" ::: "memory")
#define PG8_WAIT_L(n) asm volatile("s_waitcnt lgkmcnt(" #n ")" ::: "memory")
#define PG8_BAR __builtin_amdgcn_s_barrier()
#define PG8_SCHED __builtin_amdgcn_sched_barrier(0)
    Unit cur, nxt; int ui = 0;
    if (!S.next(0, cur)) return;
    f32x4 acc[2][2][4][2];
#pragma unroll
    for (int a = 0; a < 2; ++a)
#pragma unroll
        for (int b = 0; b < 2; ++b)
#pragma unroll
            for (int m = 0; m < 4; ++m)
#pragma unroll
                for (int n = 0; n < 2; ++n) acc[a][b][m][n] = (f32x4){0.f, 0.f, 0.f, 0.f};
    bf16x8 At[4][2], B0[2][2], B1[2][2];
    const char* cA = (const char*)g.A + (size_t)cur.pm * tstep; const char* cB = (const char*)g.Bt + (size_t)cur.pn * tstep;
    S.a_ready(cur);
    if constexpr (SP2) {
        PG8_STAGE(PG8_SB(0, 0), cB, voffB); PG8_STAGE(PG8_SB(0, 1), cB + hstep, voffB); PG8_STAGE(PG8_SA(0, 0), cA, voffA); PG8_STAGE(PG8_SA(0, 1), cA + hstep, voffA);
        if (wr == 1) PG8_BAR;
        PG8_WAIT_V(2); PG8_BAR;
        PG8_STAGE(PG8_SB(1, 0), cB + kstep, voffB); PG8_STAGE(PG8_SA(1, 0), cA + kstep, voffA); PG8_STAGE(PG8_SB(1, 1), cB + hstep + kstep, voffB);
        PG8_WAIT_V(6); PG8_BAR;
    } else {
        PG8_STAGE(PG8_SB(0, 0), cB, voffB); PG8_STAGE(PG8_SA(0, 0), cA, voffA); PG8_STAGE(PG8_SB(0, 1), cB + hstep, voffB); PG8_STAGE(PG8_SA(0, 1), cA + hstep, voffA);
        if (wr == 1) PG8_BAR;
        PG8_WAIT_V(4); PG8_BAR;
        PG8_STAGE(PG8_SB(1, 0), cB + kstep, voffB); PG8_STAGE(PG8_SA(1, 0), cA + kstep, voffA); PG8_STAGE(PG8_SB(1, 1), cB + hstep + kstep, voffB);
        PG8_WAIT_V(6); PG8_BAR;
    }
    for (;;) {
        const bool has_next = S.next(ui + 1, nxt);
        const char* nA = has_next ? (const char*)g.A + (size_t)nxt.pm * tstep : cA; const char* nB = has_next ? (const char*)g.Bt + (size_t)nxt.pn * tstep : cB;
        for (int t = 0; t < nt; t += 2) {
            const bool last = (t == nt - 2);
            const char* a1 = cA + (size_t)(t + 1) * kstep;
            const char* a2 = last ? nA : cA + (size_t)(t + 2) * kstep; const char* b2 = last ? nB : cB + (size_t)(t + 2) * kstep;
            const char* a3 = a2 + kstep; const char* b3 = b2 + kstep;
            if (last && has_next) S.a_ready(nxt);
            if constexpr (SP2) {
            PG8_LDB(B0, 0, 0); PG8_LDB(B1, 0, 1); PG8_SCHED; PG8_LDA(At, 0, 0); PG8_STAGE(PG8_SA(1, 1), a1 + hstep, voffA);
            PG8_WAIT_V(8); PG8_WAIT_L(0); PG8_BAR; PG8_MMA(0, 0, At, B0); PG8_MMA(0, 1, At, B1); PG8_BAR; PG8_SCHED;
            PG8_LDA(At, 0, 1); PG8_STAGE(PG8_SB(0, 0), b2, voffB); PG8_STAGE(PG8_SB(0, 1), b2 + hstep, voffB); PG8_STAGE(PG8_SA(0, 0), a2, voffA);
            PG8_WAIT_V(8); PG8_WAIT_L(0); PG8_BAR; PG8_MMA(1, 0, At, B0); PG8_MMA(1, 1, At, B1); PG8_BAR; PG8_SCHED;
            PG8_LDB(B0, 1, 0); PG8_LDB(B1, 1, 1); PG8_SCHED; PG8_LDA(At, 1, 0); PG8_STAGE(PG8_SA(0, 1), a2 + hstep, voffA);
            PG8_WAIT_V(8); PG8_WAIT_L(0); PG8_BAR; PG8_MMA(0, 0, At, B0); PG8_MMA(0, 1, At, B1); PG8_BAR; PG8_SCHED;
            PG8_LDA(At, 1, 1); PG8_STAGE(PG8_SB(1, 0), b3, voffB); PG8_STAGE(PG8_SB(1, 1), b3 + hstep, voffB); PG8_STAGE(PG8_SA(1, 0), a3, voffA);
            PG8_WAIT_V(8); PG8_WAIT_L(0); PG8_BAR; PG8_MMA(1, 0, At, B0); PG8_MMA(1, 1, At, B1); PG8_BAR; PG8_SCHED;
            } else {
            PG8_LDB(B0, 0, 0); PG8_SCHED; PG8_LDA(At, 0, 0); PG8_STAGE(PG8_SA(1, 1), a1 + hstep, voffA);
            PG8_WAIT_L(8); PG8_BAR; PG8_WAIT_L(0); PG8_MMA(0, 0, At, B0); PG8_BAR; PG8_SCHED;
            PG8_LDB(B1, 0, 1); PG8_STAGE(PG8_SB(0, 0), b2, voffB);
            PG8_BAR; PG8_WAIT_L(0); PG8_MMA(0, 1, At, B1); PG8_BAR;
            PG8_LDA(At, 0, 1); PG8_STAGE(PG8_SA(0, 0), a2, voffA);
            PG8_BAR; PG8_WAIT_L(0); PG8_MMA(1, 0, At, B0); PG8_BAR; PG8_SCHED;
            PG8_STAGE(PG8_SB(0, 1), b2 + hstep, voffB);
            PG8_WAIT_V(6); PG8_BAR; PG8_MMA(1, 1, At, B1); PG8_BAR;
            PG8_LDB(B0, 1, 0); PG8_SCHED; PG8_LDA(At, 1, 0); PG8_STAGE(PG8_SA(0, 1), a2 + hstep, voffA);
            PG8_WAIT_L(8); PG8_BAR; PG8_WAIT_L(0); PG8_MMA(0, 0, At, B0); PG8_BAR; PG8_SCHED;
            PG8_LDB(B1, 1, 1); PG8_STAGE(PG8_SB(1, 0), b3, voffB);
            PG8_BAR; PG8_WAIT_L(0); PG8_MMA(0, 1, At, B1); PG8_BAR;
            PG8_LDA(At, 1, 1); PG8_STAGE(PG8_SA(1, 0), a3, voffA);
            PG8_BAR; PG8_WAIT_L(0); PG8_MMA(1, 0, At, B0); PG8_BAR; PG8_SCHED;
            PG8_STAGE(PG8_SB(1, 1), b3 + hstep, voffB);
            PG8_WAIT_V(6); PG8_BAR; PG8_MMA(1, 1, At, B1); PG8_BAR;
            }
        }
        if constexpr (ALIGN_EPI) { if (wr == 0) PG8_BAR; }
        if constexpr (!Epi::AFTER_DRAIN) { E(acc, cur, wr, wc, fr, fq); S.done(cur); }
        if (!has_next) break;
#pragma unroll
        for (int a = 0; a < 2; ++a)
#pragma unroll
            for (int b = 0; b < 2; ++b)
#pragma unroll
                for (int m = 0; m < 4; ++m)
#pragma unroll
                    for (int n = 0; n < 2; ++n) acc[a][b][m][n] = (f32x4){0.f, 0.f, 0.f, 0.f};
        cur = nxt; cA = nA; cB = nB; ++ui;
        if constexpr (ALIGN_EPI) { if (wr == 1) PG8_BAR; }
    }
    PG8_WAIT_V(0);
    if constexpr (!ALIGN_EPI) { if (wr == 0) PG8_BAR; }
    PG8_BAR;
    if constexpr (Epi::AFTER_DRAIN) { E.fused(acc, cur, wr, wc, fr, fq, lds, wid, lane); S.done(cur); }
#undef PG8_SA
#undef PG8_SB
#undef PG8_STAGE
#undef PG8_LDA
#undef PG8_LDB
#undef PG8_MMA
#undef PG8_WAIT_V
#undef PG8_WAIT_L
#undef PG8_BAR
#undef PG8_SCHED
}
}
#ifndef PG8_SP2
#define PG8_SP2 true
#endif
#ifndef PG8_ALIGN
#define PG8_ALIGN true
#endif
#include <hip/hip_bf16.h>
#include <cmath>
namespace attn_body {
using bf16=__hip_bfloat16;
using bf16x8=__attribute__((ext_vector_type(8)))short;
using s16x4=__attribute__((ext_vector_type(4)))short;
using f32x16=__attribute__((ext_vector_type(16)))float;
using u32x4=__attribute__((ext_vector_type(4)))unsigned;
constexpr int BATCH=8,SEQ=2048,D=64,PZ=3584,PO=1024;
constexpr int NW=8,QBLK=32,QB=QBLK*NW,KVBLK=64,NQB=SEQ/QB;
constexpr int ATTN_UNIT_ROWS=QB;
__device__ __forceinline__ int crow(int r,int hi){return (r&3)+8*(r>>2)+4*hi;}
#define SBAR() __builtin_amdgcn_sched_barrier(0)
__device__ __forceinline__ void cmask(f32x16&p0,f32x16&p1,int jb,int qrel,int hi){
  const float NEG=-INFINITY; int kb=64*jb+4*hi;
  #pragma unroll
  for(int r=0;r<16;++r){int kv=kb+(r&3)+8*(r>>2); if(kv>qrel)p0[r]=NEG; if(kv+32>qrel)p1[r]=NEG;}
}

constexpr int NSLOT=3, SLOTB=8192;
constexpr int LDS_K=0, LDS_V=NSLOT*SLOTB, LDS_WS=2*NSLOT*SLOTB, LDS_OST=LDS_WS+NW*64*4, LDS_BYTES=LDS_OST+NW*4096;
constexpr float C2=0.125f*1.4426950408889634f;
__device__ __forceinline__ void glds16(const void*gsrc,unsigned lds_dst){unsigned keep;
  asm volatile("s_mov_b32 %0, m0\n\ts_mov_b32 m0, %2\n\ts_nop 0\n\tglobal_load_lds_dwordx4 %1, off\n\ts_mov_b32 m0, %0":"=&s"(keep):"v"(gsrc),"s"(lds_dst):"memory");}
__device__ __forceinline__ float max3f(float a,float b,float c){float r;asm("v_max3_f32 %0, %1, %2, %3":"=v"(r):"v"(a),"v"(b),"v"(c));return r;}
__device__ __forceinline__ float max2f(float a,float b){float r;asm("v_max_f32_e32 %0, %1, %2":"=v"(r):"v"(a),"v"(b));return r;}
__device__ __forceinline__ float fadd_s(float a,float b){float r;asm("v_add_f32_e32 %0, %1, %2":"=v"(r):"v"(a),"v"(b));return r;}
__device__ __forceinline__ float fsub_s(float a,float b){float r;asm("v_sub_f32_e32 %0, %1, %2":"=v"(r):"v"(a),"v"(b));return r;}
typedef float f32x2_t __attribute__((ext_vector_type(2))); typedef __bf16 bf16x2_t __attribute__((ext_vector_type(2)));
__device__ __forceinline__ unsigned cvtpk_s(float lo,float hi){f32x2_t v={lo,hi};bf16x2_t b=__builtin_convertvector(v,bf16x2_t);return __builtin_bit_cast(unsigned,b);}
#define WAIT_BAR(N) asm volatile("s_waitcnt vmcnt(" #N ") lgkmcnt(0)\n\ts_barrier":::"memory")

__device__ __forceinline__ void qkt(f32x16&p0,f32x16&p1,const char*Kslot,const bf16x8*qr,const f32x16&negm,int r32,int hi){
  const char*kb=Kslot+hi*1024+r32*16;
  #pragma unroll
  for(int d0=0;d0<4;++d0){
    const bf16x8 b0=*reinterpret_cast<const bf16x8*>(kb+d0*2048);
    const bf16x8 b1=*reinterpret_cast<const bf16x8*>(kb+d0*2048+512);
    if(d0==0){p0=__builtin_amdgcn_mfma_f32_32x32x16_bf16(b0,qr[0],negm,0,0,0);p1=__builtin_amdgcn_mfma_f32_32x32x16_bf16(b1,qr[0],negm,0,0,0);}
    else{p0=__builtin_amdgcn_mfma_f32_32x32x16_bf16(b0,qr[d0],p0,0,0,0);p1=__builtin_amdgcn_mfma_f32_32x32x16_bf16(b1,qr[d0],p1,0,0,0);}}
}
typedef __attribute__((address_space(3))) const char* lds_cptr;
typedef short v4i16_t __attribute__((ext_vector_type(4)));
__device__ __forceinline__ void kload8(bf16x8*kf,lds_cptr kp){
  kf[0]=*(const __attribute__((address_space(3))) bf16x8*)(kp);      kf[1]=*(const __attribute__((address_space(3))) bf16x8*)(kp+512);
  kf[2]=*(const __attribute__((address_space(3))) bf16x8*)(kp+2048); kf[3]=*(const __attribute__((address_space(3))) bf16x8*)(kp+2560);
  kf[4]=*(const __attribute__((address_space(3))) bf16x8*)(kp+4096); kf[5]=*(const __attribute__((address_space(3))) bf16x8*)(kp+4608);
  kf[6]=*(const __attribute__((address_space(3))) bf16x8*)(kp+6144); kf[7]=*(const __attribute__((address_space(3))) bf16x8*)(kp+6656);
}
__device__ __forceinline__ void kload2(bf16x8*kf,lds_cptr kp,int j){ kf[2*j]=*(const __attribute__((address_space(3))) bf16x8*)(kp+j*2048); kf[2*j+1]=*(const __attribute__((address_space(3))) bf16x8*)(kp+j*2048+512); }
__device__ __forceinline__ s16x4 vtr(lds_cptr p){ return __builtin_bit_cast(s16x4,__builtin_amdgcn_ds_read_tr16_b64_v4i16((__attribute__((address_space(3))) v4i16_t*)p)); }
__device__ __forceinline__ float rowmax(const f32x16&p0,const f32x16&p1){
  float a=max3f(p0[0],p0[1],p1[0]),b=max3f(p0[2],p0[3],p1[1]);a=max3f(a,p1[2],p1[3]);
  #pragma unroll
  for(int r=4;r<16;r+=4){a=max3f(a,p0[r],p0[r+1]);b=max3f(b,p0[r+2],p0[r+3]);a=max3f(a,p1[r],p1[r+1]);b=max3f(b,p1[r+2],p1[r+3]);}
  const float m=max2f(a,b);
  auto rr=__builtin_amdgcn_permlane32_swap(__float_as_uint(m),__float_as_uint(m),false,false);
  return max2f(__uint_as_float(rr[0]),__uint_as_float(rr[1]));
}
__device__ __forceinline__ void pv(f32x16*o,int vb,bf16x8 pa0,bf16x8 pa1,bf16x8 pa2,bf16x8 pa3){
  #pragma unroll
  for(int d0=0;d0<2;++d0){s16x4 lo[4],hi[4];
    #pragma unroll
    for(int ks=0;ks<4;++ks){
      asm volatile("ds_read_b64_tr_b16 %0,%1 offset:%c2":"=&v"(lo[ks]):"v"(vb),"i"(d0*4096+ks*1024):"memory");
      asm volatile("ds_read_b64_tr_b16 %0,%1 offset:%c2":"=&v"(hi[ks]):"v"(vb),"i"(d0*4096+ks*1024+512):"memory");}
    asm volatile("s_waitcnt lgkmcnt(0)":::"memory");SBAR();
    #define PK(k) (bf16x8){lo[k][0],lo[k][1],lo[k][2],lo[k][3],hi[k][0],hi[k][1],hi[k][2],hi[k][3]}
    o[d0]=__builtin_amdgcn_mfma_f32_32x32x16_bf16(pa0,PK(0),o[d0],0,0,0);
    o[d0]=__builtin_amdgcn_mfma_f32_32x32x16_bf16(pa1,PK(1),o[d0],0,0,0);
    o[d0]=__builtin_amdgcn_mfma_f32_32x32x16_bf16(pa2,PK(2),o[d0],0,0,0);
    o[d0]=__builtin_amdgcn_mfma_f32_32x32x16_bf16(pa3,PK(3),o[d0],0,0,0);
    #undef PK
  }
}

#ifndef ATTN_STORE16
#define ATTN_STORE16(p,v) (*(u32x4*)(p)=(v))
#endif
template<int THRL> __device__ __forceinline__ void attn_unit(int b,int qb,const bf16*Q,const bf16*__restrict__ K,const bf16*__restrict__ V,bf16*O,float sl2,char*shm){
  const int tid=threadIdx.x,lane=tid&63,r32=lane&31,hi=lane>>5; const int wid=__builtin_amdgcn_readfirstlane(tid>>6);
  const long rowbase=(long)b*SEQ; const int q0=qb*QB;
  const bf16*Qw=Q+(rowbase+q0+wid*QBLK)*PZ;
  const bf16*Kh=K+rowbase*PZ,*Vh=V+rowbase*PZ;
  const unsigned lds0=(unsigned)(uintptr_t)shm;
  float*wsf=(float*)(shm+LDS_WS)+wid*64;
  const bf16*ksrc=Kh+(long)lane*PZ+wid*8;
  const bf16*vsrc=Vh+(long)(16*(wid&3)+(lane>>2))*PZ+(wid>>2)*32+(lane&3)*8;
  const unsigned kdst=lds0+LDS_K+wid*1024, vdst=lds0+LDS_V+wid*1024;
  #define DMA_K(t,slot) glds16(ksrc+(long)(t)*KVBLK*PZ,(unsigned)__builtin_amdgcn_readfirstlane(kdst+(slot)))
  #define DMA_V(t,slot) glds16(vsrc+(long)(t)*KVBLK*PZ,(unsigned)__builtin_amdgcn_readfirstlane(vdst+(slot)))
  const int vb0=(int)(lds0+LDS_V)+((lane>>4)&1)*32+(lane&3)*8+(4*hi+((lane&15)>>2))*64;
  const char*Kbase=shm+LDS_K; bf16x8 kf[8];
  const lds_cptr shm3=(lds_cptr)shm; const lds_cptr kp0=shm3+LDS_K+hi*1024+r32*16; const lds_cptr vp0=shm3+LDS_V+((lane>>4)&1)*32+(lane&3)*8+(4*hi+((lane&15)>>2))*64;
  const int NT=(q0+QB)/KVBLK;
  DMA_K(0,0);DMA_V(0,0);DMA_K(1,SLOTB);
  bf16x8 qr[4];
  #pragma unroll
  for(int d0=0;d0<4;++d0)qr[d0]=*reinterpret_cast<const bf16x8*>(&Qw[(long)r32*PZ+d0*16+hi*8]);
  float mhat=0.f,l_reg=0.f;f32x16 o[2];o[0]=f32x16{};o[1]=f32x16{};f32x16 negm; const float s64=__builtin_bit_cast(float,__builtin_amdgcn_readfirstlane(__builtin_bit_cast(int,64.f*sl2))),s32=__builtin_bit_cast(float,__builtin_amdgcn_readfirstlane(__builtin_bit_cast(int,32.f*sl2)));
  _Pragma("unroll") for(int r=0;r<16;++r)negm[r]=sl2*(float)crow(r,hi);
  asm volatile("":"+v"(negm));
  const int qrel=wid*QBLK+r32;
  #define CMASK(P0,P1,t) do{int jb_=(t)-(NT-4); if(jb_>=0)cmask(P0,P1,jb_,qrel,hi);}while(0)
  bool resc=false;
  #define START(P0,P1) do{ const float rm=rowmax(P0,P1); resc=false; \
    { const float dl=rm; mhat=fadd_s(mhat,dl); \
      _Pragma("unroll") for(int r=0;r<16;++r){P0[r]=fsub_s(P0[r],dl);P1[r]=fsub_s(P1[r],dl);} \
      _Pragma("unroll") for(int r=0;r<16;++r)negm[r]-=dl; asm volatile("":"+v"(negm)); } \
    _Pragma("unroll") for(int r=0;r<16;++r)P0[r]=__builtin_amdgcn_exp2f(P0[r]); }while(0)
  #define RESC() do{ if(resc){ asm volatile("s_waitcnt lgkmcnt(0)":::"memory"); \
      _Pragma("unroll") for(int d_=0;d_<2;++d_) _Pragma("unroll") for(int r=0;r<16;++r)o[d_][r]*=wsf[crow(r,hi)]; } }while(0)
  f32x16 pA0,pA1,pB0,pB1;
  int sl_prev=0,sl_cur=0,sl_next=SLOTB;
  #define ROT() do{sl_prev=sl_cur;sl_cur=sl_next;sl_next=(sl_next==(NSLOT-1)*SLOTB)?0:sl_next+SLOTB;}while(0)
  DMA_K(2,2*SLOTB);
  WAIT_BAR(3);
  qkt(pA0,pA1,Kbase,qr,negm,r32,hi);asm volatile("s_nop 15\n\ts_nop 7":"+v"(pA0),"+v"(pA1));
  _Pragma("unroll") for(int r=0;r<16;++r)pA1[r]+=s32;
  CMASK(pA0,pA1,0);
  START(pA0,pA1);
  _Pragma("unroll") for(int r=0;r<16;++r)pA1[r]=__builtin_amdgcn_exp2f(pA1[r]);
  WAIT_BAR(0);
  DMA_K(3,0);DMA_V(1,SLOTB);
  ROT();
  kload8(kf,kp0+sl_cur);
  WAIT_BAR(2);
  s16x4 vlo[8],vhi[8]; u32x4 pw0,pw1,pw2,pw3;
  #define PKW(P,B) cvtpk_s(P[B],P[B+1])
  #define PAF(k) __builtin_bit_cast(bf16x8,pw##k)
  #define VFR(i) (bf16x8){vlo[i][0],vlo[i][1],vlo[i][2],vlo[i][3],vhi[i][0],vhi[i][1],vhi[i][2],vhi[i][3]}
  #define PIN(x) asm volatile("":"+v"(x))
  #define MX3(a,b,c) __builtin_fmaxf(__builtin_fmaxf((a),(b)),(c))
  #define GAPA(MF,A0,A1,A2,A3,W0,W1,PW) do{ MF; sacc+=A0; sacc+=A1; sacc+=A2; sacc+=A3; PIN(sacc); W0; W1; PIN(PW); SBAR(); }while(0)
  #define EX(v) __builtin_amdgcn_exp2f(v)
  #define GAPB(MF,X,B) do{ MF; X[B]=EX(X[B]); X[B+1]=EX(X[B+1]); X[B+2]=EX(X[B+2]); X[B+3]=EX(X[B+3]); PIN(X); SBAR(); }while(0)
  #define VRD(i) do{ vlo[i]=vtr(vp_+(((i)>>2)*4096+((i)&3)*1024)); vhi[i]=vtr(vp_+(((i)>>2)*4096+((i)&3)*1024+512)); }while(0)
  #define KRD(G,j) do{ if(G){ kload2(kf,kp0+sl_next,j); SBAR(); } }while(0)
  #define STEP(C0,C1,P0,P1,t,GK,GV,GL) do{ _Pragma("unroll") for(int r_=0;r_<16;++r_)negm[r_]+=s64; asm volatile("":"+v"(negm)); SBAR(); \
    const lds_cptr vp_=vp0+sl_prev; \
    VRD(0); SBAR(); float sacc=(P0[0]+P0[1]); \
    GAPA(C0=__builtin_amdgcn_mfma_f32_32x32x16_bf16(kf[0],qr[0],negm,0,0,0), P0[2],P0[3],P0[4],P0[5],     pw0[0]=PKW(P0,0), pw0[1]=PKW(P0,2), pw0); \
    VRD(4); SBAR(); GAPA(C1=__builtin_amdgcn_mfma_f32_32x32x16_bf16(kf[1],qr[0],negm,0,0,0), P0[6],P0[7],P0[8],P0[9],     pw0[2]=PKW(P0,4), pw0[3]=PKW(P0,6), pw0); \
    VRD(1); SBAR(); GAPA(C0=__builtin_amdgcn_mfma_f32_32x32x16_bf16(kf[2],qr[1],C0,0,0,0),   P0[10],P0[11],P0[12],P0[13], pw1[0]=PKW(P0,8), pw1[1]=PKW(P0,10), pw1); \
    VRD(5); SBAR(); GAPA(C1=__builtin_amdgcn_mfma_f32_32x32x16_bf16(kf[3],qr[1],C1,0,0,0),   P0[14],P0[15],P1[0],P1[1],   pw1[2]=PKW(P0,12),pw1[3]=PKW(P0,14), pw1); \
    VRD(2); SBAR(); GAPA(C0=__builtin_amdgcn_mfma_f32_32x32x16_bf16(kf[4],qr[2],C0,0,0,0),   P1[2],P1[3],P1[4],P1[5],     pw2[0]=PKW(P1,0), pw2[1]=PKW(P1,2), pw2); \
    VRD(6); SBAR(); GAPA(C1=__builtin_amdgcn_mfma_f32_32x32x16_bf16(kf[5],qr[2],C1,0,0,0),   P1[6],P1[7],P1[8],P1[9],     pw2[2]=PKW(P1,4), pw2[3]=PKW(P1,6), pw2); \
    VRD(3); SBAR(); GAPA(C0=__builtin_amdgcn_mfma_f32_32x32x16_bf16(kf[6],qr[3],C0,0,0,0),   P1[10],P1[11],P1[12],P1[13], pw3[0]=PKW(P1,8), pw3[1]=PKW(P1,10), pw3); \
    VRD(7); SBAR(); GAPA(C1=__builtin_amdgcn_mfma_f32_32x32x16_bf16(kf[7],qr[3],C1,0,0,0),   P1[14],P1[15],0.f,0.f,       pw3[2]=PKW(P1,12),pw3[3]=PKW(P1,14), pw3); \
    l_reg+=sacc; \
    if(GK){DMA_K((t)+3,sl_cur);} if(GV){DMA_V((t)+1,sl_next);} \
    _Pragma("unroll") for(int r_=0;r_<16;++r_)C1[r_]+=s32; \
    CMASK(C0,C1,t); \
    { float a=MX3(C0[0],C0[1],C1[0]),b=MX3(C0[2],C0[3],C1[1]); a=MX3(a,C1[2],C1[3]); \
      _Pragma("unroll") for(int r=4;r<16;r+=4){a=MX3(a,C0[r],C0[r+1]);b=MX3(b,C0[r+2],C0[r+3]);a=MX3(a,C1[r],C1[r+1]);b=MX3(b,C1[r+2],C1[r+3]);} \
      float rm=__builtin_fmaxf(a,b); { auto rr=__builtin_amdgcn_permlane32_swap(__float_as_uint(rm),__float_as_uint(rm),false,false); rm=__builtin_fmaxf(__uint_as_float(rr[0]),__uint_as_float(rr[1])); } \
      resc=false; \
      if(__builtin_expect(__any(rm>(float)THRL),0)){ const float dl=__builtin_fmaxf(rm,0.f); mhat+=dl; \
        _Pragma("unroll") for(int r=0;r<16;++r){C0[r]-=dl;C1[r]-=dl;} \
        _Pragma("unroll") for(int r=0;r<16;++r)negm[r]-=dl; asm volatile("":"+v"(negm)); \
        const float f=__builtin_amdgcn_exp2f(-dl); l_reg*=f; if(hi==0)wsf[r32]=f; resc=true; } } \
    SBAR(); \
    GAPB(o[0]=__builtin_amdgcn_mfma_f32_32x32x16_bf16(PAF(0),VFR(0),o[0],0,0,0), C0,0); \
    GAPB(o[1]=__builtin_amdgcn_mfma_f32_32x32x16_bf16(PAF(0),VFR(4),o[1],0,0,0), C0,4); \
    KRD(GL,0); GAPB(o[0]=__builtin_amdgcn_mfma_f32_32x32x16_bf16(PAF(1),VFR(1),o[0],0,0,0), C0,8); \
    KRD(GL,1); GAPB(o[1]=__builtin_amdgcn_mfma_f32_32x32x16_bf16(PAF(1),VFR(5),o[1],0,0,0), C0,12); \
    KRD(GL,2); GAPB(o[0]=__builtin_amdgcn_mfma_f32_32x32x16_bf16(PAF(2),VFR(2),o[0],0,0,0), C1,0); \
    KRD(GL,3); GAPB(o[1]=__builtin_amdgcn_mfma_f32_32x32x16_bf16(PAF(2),VFR(6),o[1],0,0,0), C1,4); \
    GAPB(o[0]=__builtin_amdgcn_mfma_f32_32x32x16_bf16(PAF(3),VFR(3),o[0],0,0,0), C1,8); \
    GAPB(o[1]=__builtin_amdgcn_mfma_f32_32x32x16_bf16(PAF(3),VFR(7),o[1],0,0,0), C1,12); \
    }while(0)
  int t=1;
  #undef CMASK
  #define CMASK(P0,P1,t) do{}while(0)
  for(;t+5<NT;t+=2){
    STEP(pB0,pB1,pA0,pA1,t,true,true,true);     WAIT_BAR(2); RESC(); ROT();
    STEP(pA0,pA1,pB0,pB1,t+1,true,true,true);   WAIT_BAR(2); RESC(); ROT();
  }
  #undef CMASK
  #define CMASK(P0,P1,t) do{int jb_=(t)-(NT-4); if(jb_>=0)cmask(P0,P1,jb_,qrel,hi);}while(0)
  #define ENDW(tt) do{ if((tt)+3<NT){WAIT_BAR(2);} else if((tt)+2<NT){WAIT_BAR(1);} else {WAIT_BAR(0);} }while(0)
  for(;t+1<NT;t+=2){
    STEP(pB0,pB1,pA0,pA1,t,(t+3<NT),(t+1<NT),(t+1<NT));       ENDW(t);   RESC(); ROT();
    STEP(pA0,pA1,pB0,pB1,t+1,(t+4<NT),(t+2<NT),(t+2<NT));     ENDW(t+1); RESC(); ROT();
  }
  STEP(pB0,pB1,pA0,pA1,NT-1,false,false,false); RESC();
  { float sacc=pB0[0]+pB0[1]; _Pragma("unroll") for(int r=2;r<16;++r)sacc+=pB0[r]; _Pragma("unroll") for(int r=0;r<16;++r)sacc+=pB1[r]; l_reg+=sacc;
    pw0=(u32x4){PKW(pB0,0),PKW(pB0,2),PKW(pB0,4),PKW(pB0,6)};pw1=(u32x4){PKW(pB0,8),PKW(pB0,10),PKW(pB0,12),PKW(pB0,14)};pw2=(u32x4){PKW(pB1,0),PKW(pB1,2),PKW(pB1,4),PKW(pB1,6)};pw3=(u32x4){PKW(pB1,8),PKW(pB1,10),PKW(pB1,12),PKW(pB1,14)};
    SBAR(); pv(o,vb0+sl_cur,PAF(0),PAF(1),PAF(2),PAF(3)); }
  #undef PKW
  #undef PAF
  #undef VFR
  #undef PIN
  #undef MX3
  #undef GAPA
  #undef GAPB
  #undef EX
  #undef VRD
  #undef KRD
  #undef STEP
  #undef ENDW
  {auto rr=__builtin_amdgcn_permlane32_swap(__float_as_uint(l_reg),__float_as_uint(l_reg),false,false);l_reg=__uint_as_float(rr[0])+__uint_as_float(rr[1]);}
  int le=lane; asm volatile("":"+v"(le)); const int r32e=le&31,hie=le>>5;
  if(hie==0)wsf[32+r32e]=l_reg;asm volatile("s_waitcnt lgkmcnt(0)":::"memory");
  float rli[16];
  #pragma unroll
  for(int r=0;r<16;++r)rli[r]=__builtin_amdgcn_rcpf(wsf[32+crow(r,hie)]);
  bf16*Ow=O+(rowbase+q0+wid*QBLK)*PO;
  { bf16*stg=(bf16*)(shm+LDS_OST)+wid*2048;
    #pragma unroll
    for(int r=0;r<16;++r){const int orow=crow(r,hie);
      #pragma unroll
      for(int d0=0;d0<2;++d0)stg[orow*64+d0*32+r32e]=__float2bfloat16(o[d0][r]*rli[r]);}
    asm volatile("s_waitcnt lgkmcnt(0)":::"memory");
    #pragma unroll
    for(int i=0;i<4;++i){const int row=i*8+(le>>3),ch=le&7; const u32x4 v=*(const u32x4*)(stg+row*64+ch*8); ATTN_STORE16(Ow+(long)row*PO+ch*8,v);} }
  asm volatile("s_waitcnt lgkmcnt(0)\n\ts_barrier":::"memory");
  #undef DMA_K
  #undef DMA_V
  #undef CMASK
  #undef START
  #undef RESC
  #undef ROT
}
constexpr int ATTN_LDS_BYTES=LDS_BYTES;
#undef SBAR
#undef WAIT_BAR
}
constexpr int NWAVES = 8;

constexpr int D = 1024, NB = 8, T = 2048, MP = NB * T, DB = 128, MT = MP + DB, MPAD = 16640;
constexpr int NIN = 3584, DFF = 2816, NFF2 = 5632;
constexpr int CQ = 0, CK = 512, CV = 1024, CG = 1536, CDQ = 2048, CDK = 2560, CDV = 3072;
constexpr float EPS = 1e-6f;
constexpr float RK_SCALE = 0.08838834764831845f;
constexpr float LOG2E = 1.4426950408889634f;
constexpr float QC2 = 0.125f * LOG2E;
constexpr size_t O_Y = 0, O_YS = O_Y + (size_t)MP * D, O_RSP = O_YS + (size_t)DB * D, O_RSS = O_RSP + (size_t)NB * 4 * 128 * 128,
                 O_KP = O_RSS + (size_t)DB * 4 * 128 * 128, O_VP = O_KP + (size_t)MP * 512, O_KS = O_VP + (size_t)MP * 512, O_VS = O_KS + (size_t)DB * 512,
                 O_CP = O_VS + (size_t)DB * 512, O_CS = O_CP + (size_t)NB * 2 * DFF, O_END = O_CS + (size_t)DB * 2 * DFF;
static_assert(O_END == 43495424, "output size");

constexpr size_t MiB = 1u << 20;
constexpr size_t WS_CTL = 0, CTL_ZERO_BYTES = 1 * MiB;
constexpr size_t WS_WIN = 1 * MiB, WS_WO = 8 * MiB, WS_WF1 = 10 * MiB, WS_WF2 = 21 * MiB;
constexpr size_t WS_XN = 27 * MiB;
constexpr size_t WS_Z = 60 * MiB;
constexpr size_t WS_ATT = 174 * MiB;
constexpr size_t WS_KV = 206 * MiB;
constexpr size_t WS_PART = 238 * MiB;
constexpr size_t WS_MIX = 247 * MiB;
constexpr size_t WS_T1 = 280 * MiB;
constexpr size_t WS_X1 = 345 * MiB;
constexpr size_t WS_XN2 = 410 * MiB;
constexpr size_t WS_ZF = 443 * MiB;
constexpr size_t WS_ACT = 622 * MiB;
constexpr size_t WS_T2 = 712 * MiB;
constexpr size_t WS_END = 777 * MiB;
static_assert(WS_WIN + (size_t)NIN * D * 2 <= WS_WO && WS_WO + (size_t)D * D * 2 <= WS_WF1 && WS_WF1 + (size_t)NFF2 * D * 2 <= WS_WF2 && WS_WF2 + (size_t)D * DFF * 2 <= WS_XN, "ws map 1");
static_assert(WS_XN + (size_t)MPAD * D * 2 <= WS_Z && WS_Z + (size_t)MPAD * NIN * 2 <= WS_ATT && WS_ATT + (size_t)MP * 1024 * 2 <= WS_KV && WS_KV + (size_t)512 * 65536 <= WS_PART, "ws map 2");
static_assert(WS_PART + (size_t)2048 * 8 * 132 * 4 <= WS_MIX && WS_MIX + (size_t)MPAD * D * 2 <= WS_T1 && WS_T1 + (size_t)MPAD * D * 4 <= WS_X1 && WS_X1 + (size_t)MPAD * D * 4 <= WS_XN2, "ws map 3");
static_assert(WS_XN2 + (size_t)MPAD * D * 2 <= WS_ZF && WS_ZF + (size_t)MPAD * NFF2 * 2 <= WS_ACT && WS_ACT + (size_t)MPAD * DFF * 2 <= WS_T2 && WS_T2 + (size_t)MPAD * D * 4 <= WS_END, "ws map 4");
constexpr int CW_BAR = 4096;

constexpr int RING_OFF = 0, RING_BYTES = 131072;
constexpr int LDSCTL_OFF = RING_BYTES, MISC_OFF = LDSCTL_OFF + 320;
constexpr int LDS_BYTES = 147456;
static_assert(MISC_OFF + 128 <= LDS_BYTES, "LDS map");
#define GAS __attribute__((address_space(1)))
#define LAS __attribute__((address_space(3)))
typedef unsigned short bf16;
typedef unsigned v4u __attribute__((ext_vector_type(4)));
typedef float f32x4 __attribute__((ext_vector_type(4)));
typedef short bf16x8 __attribute__((ext_vector_type(8)));
typedef GAS unsigned gu32;
typedef GAS unsigned long long gu64;
#define RLX_AGENT __ATOMIC_RELAXED, __HIP_MEMORY_SCOPE_AGENT
#define LDS_WAIT() asm volatile("s_waitcnt lgkmcnt(0)" ::: "memory")
#define VM_WAIT() asm volatile("s_waitcnt vmcnt(0)" ::: "memory")
__device__ __forceinline__ unsigned long long rt() { return __builtin_amdgcn_s_memrealtime(); }
__device__ __forceinline__ unsigned f2bf(float f) { unsigned u = __builtin_bit_cast(unsigned, f); return (u + 0x7fffu + ((u >> 16) & 1u)) >> 16; }
__device__ __forceinline__ unsigned pk2(float lo, float hi) { return f2bf(lo) | (f2bf(hi) << 16); }

#define XB_TMO      128
#define XB_XCNT(j)  (256  + 64 * (j))
#define XB_XSUB(j)  (1280 + 64 * (j))
#define XB_XGEN(j)  (2304 + 64 * (j))
#define XB_TOP      3328
#define XB_TOPGEN   3392
#define XCD_BAR_WORDS 3456
#define XB_SPIN_CAP (1u << 18)

__device__ __forceinline__ unsigned xb_ld(unsigned* p)              { return __hip_atomic_load(p, __ATOMIC_RELAXED, __HIP_MEMORY_SCOPE_AGENT); }
__device__ __forceinline__ unsigned xb_add(unsigned* p, unsigned v) { return __hip_atomic_fetch_add(p, v, __ATOMIC_RELAXED, __HIP_MEMORY_SCOPE_AGENT); }
__device__ __forceinline__ unsigned xb_xcc_id() { return (unsigned)__builtin_amdgcn_s_getreg((3 << 11) | 20) & 0xFu; }
#define XB_SPIN(cond, bar) do { unsigned _sp = 0; while (cond) { __builtin_amdgcn_s_sleep(1); \
    if ((++_sp & 255u) == 0u) { if (xb_ld(&(bar)[XB_TMO])) break; if (_sp > XB_SPIN_CAP) { atomicAdd(&(bar)[XB_TMO], 1u); break; } } } } while (0)

struct XcdBarrier {
    unsigned* bar; unsigned x;
    volatile LAS unsigned* st;
};

__device__ __forceinline__ XcdBarrier xcd_barrier_post(unsigned* bar, volatile LAS unsigned* st) {
    XcdBarrier b; b.bar = bar; b.x = xb_xcc_id(); b.st = st;
    if (threadIdx.x == 0) (void)xb_add(&bar[XB_XCNT(b.x)], 1u);
    return b;
}
__device__ __forceinline__ void xcd_barrier_complete(unsigned* bar, unsigned x, unsigned& nloc, unsigned& nx) {
    const unsigned G = gridDim.x * gridDim.y * gridDim.z;
    unsigned sum, cnt, mine, sp = 0u;
    for (;;) {
        sum = 0u; cnt = 0u; mine = 0u;
#pragma unroll
        for (unsigned j = 0; j < 16; ++j) { const unsigned c = xb_ld(&bar[XB_XCNT(j)]); sum += c; cnt += (c > 0u) ? 1u : 0u; mine = (j == x) ? c : mine; }
        if (sum == G) break;
        __builtin_amdgcn_s_sleep(1);
        if ((++sp & 255u) == 0u) { if (xb_ld(&bar[XB_TMO])) break; if (sp > XB_SPIN_CAP) { atomicAdd(&bar[XB_TMO], 1u); break; } }
    }
    nloc = mine > 0u ? mine : 1u; nx = cnt > 0u ? cnt : 1u;
}

__device__ __forceinline__ void xcd_barrier(const XcdBarrier& b) {
    asm volatile("s_waitcnt vmcnt(0)" ::: "memory");
    __syncthreads();
    if (threadIdx.x == 0) {
        unsigned* bar = b.bar;
        __builtin_amdgcn_s_waitcnt(0);
        unsigned nloc = b.st[0], nx = b.st[1];
        if (nloc == 0u) { xcd_barrier_complete(bar, b.x, nloc, nx); b.st[0] = nloc; b.st[1] = nx; }
        const unsigned old = xb_add(&bar[XB_XSUB(b.x)], 1u);
        const unsigned gen = old / nloc;
        if (old + 1u == (gen + 1u) * nloc) {
            __builtin_amdgcn_fence(__ATOMIC_RELEASE, "agent");
            asm volatile("s_waitcnt vmcnt(0)" ::: "memory");
            const unsigned og = xb_add(&bar[XB_TOP], 1u);
            const unsigned tg = og / nx;
            if (og + 1u == (tg + 1u) * nx) xb_add(&bar[XB_TOPGEN], 1u);
            else XB_SPIN(xb_ld(&bar[XB_TOPGEN]) == tg, bar);
            __builtin_amdgcn_fence(__ATOMIC_ACQUIRE, "agent");
            xb_add(&bar[XB_XGEN(b.x)], 1u);
            asm volatile("s_waitcnt vmcnt(0)" ::: "memory");
        } else {
            XB_SPIN(xb_ld(&bar[XB_XGEN(b.x)]) == gen, bar);
            __builtin_amdgcn_fence(__ATOMIC_ACQUIRE, "agent");
            asm volatile("s_waitcnt vmcnt(0)" ::: "memory");
        }
    }
    __syncthreads();
}
typedef float f32x2 __attribute__((ext_vector_type(2)));
typedef unsigned u32x2 __attribute__((ext_vector_type(2)));
typedef const __attribute__((address_space(4))) unsigned long long* kargp_t;
#define KIN(k, T) ((T)(__attribute__((address_space(1))) void*)(((kargp_t)__builtin_amdgcn_kernarg_segment_ptr())[k]))
struct Frame {
    LAS unsigned char* lds;
    volatile LAS unsigned* MISC;
    gu32* ctl;
    int tid, lane, wave;
    int vcu, G;
    unsigned char* ws; float* out;
};

__device__ __forceinline__ float wave_sum(float v) {
#pragma unroll
    for (int o = 1; o < 64; o <<= 1) v += __shfl_xor(v, o);
    return v;
}
__device__ __forceinline__ float sum16(float v) {
    v += __shfl_xor(v, 1); v += __shfl_xor(v, 2); v += __shfl_xor(v, 4); v += __shfl_xor(v, 8); return v;
}
__device__ __forceinline__ float bf2f(bf16 v) { return __uint_as_float((unsigned)v << 16); }
__device__ __forceinline__ float bflo(unsigned w) { return __uint_as_float(w << 16); }
__device__ __forceinline__ float bfhi(unsigned w) { return __uint_as_float(w & 0xffff0000u); }
__device__ __forceinline__ float ex2(float x) { return __builtin_amdgcn_exp2f(x); }
__device__ __forceinline__ float silu_f(float g) { return g * __builtin_amdgcn_rcpf(1.f + ex2(-g * LOG2E)); }
__device__ __forceinline__ float gelu_tanh_f(float c) {
    const float y2 = 1.5957691216057308f * (c + 0.044715f * c * c * c);
    return c * __builtin_amdgcn_rcpf(1.f + ex2(-y2 * LOG2E));
}
__device__ __forceinline__ float lambda_of(const Frame& F) {
    const float a = wave_sum(KIN(11, const float*)[F.lane] * KIN(12, const float*)[F.lane]), b = wave_sum(KIN(13, const float*)[F.lane] * KIN(14, const float*)[F.lane]);
    return expf(a) - expf(b) + 0.2f;
}
#define WG_SYNC() __syncthreads()

__device__ __forceinline__ void p0_transpose_item(const float* W, int K, int N, bf16* WT, LAS float* scr, int item, int lane) {
    const int nblk = N / 32, kb = item / nblk, nb = item % nblk, k0 = 64 * kb, n0 = 32 * nb;
#pragma unroll 8
    for (int i = 0; i < 32; ++i) { const int kk = 2 * i + (lane >> 5); scr[kk * 33 + (lane & 31)] = W[(size_t)(k0 + kk) * N + n0 + (lane & 31)]; }
    LDS_WAIT(); asm volatile("" ::: "memory");
    const int c = lane & 7;
#pragma unroll
    for (int j = 0; j < 4; ++j) { const int n = (lane >> 3) + 8 * j; const LAS float* s = scr + (8 * c) * 33 + n;
        v4u o; o.x = pk2(s[0 * 33], s[1 * 33]); o.y = pk2(s[2 * 33], s[3 * 33]); o.z = pk2(s[4 * 33], s[5 * 33]); o.w = pk2(s[6 * 33], s[7 * 33]);
        *(GAS v4u*)(WT + (size_t)(n0 + n) * K + k0 + 8 * c) = o; }
    LDS_WAIT(); asm volatile("" ::: "memory");
}
__device__ __forceinline__ void rms_row_to_bf16(int lane, const float* xrow, const float* g, bf16* orow) {
    const GAS f32x4* xr = (const GAS f32x4*)xrow + lane;
    f32x4 v[4]; float s = 0.f;
#pragma unroll
    for (int j = 0; j < 4; ++j) { v[j] = xr[64 * j]; s += (v[j].x * v[j].x + v[j].y * v[j].y) + (v[j].z * v[j].z + v[j].w * v[j].w); }
    const float rs = rsqrtf(wave_sum(s) * (1.f / D) + EPS);
    GAS unsigned long long* o8 = (GAS unsigned long long*)orow + lane;
#pragma unroll
    for (int j = 0; j < 4; ++j) { const f32x4 gg = ((const GAS f32x4*)g)[lane + 64 * j];
        o8[64 * j] = (unsigned long long)pk2(v[j].x * rs * gg.x, v[j].y * rs * gg.y) | ((unsigned long long)pk2(v[j].z * rs * gg.z, v[j].w * rs * gg.w) << 32); }
}
__device__ __forceinline__ void zero_row_bf16(int lane, bf16* orow, int ncols) {
    for (int c = lane * 8; c < ncols; c += 512) *(GAS v4u*)(orow + c) = (v4u){0u, 0u, 0u, 0u};
}
__device__ __forceinline__ void p0_prologue(Frame& F) {
    LAS float* scr = (LAS float*)(F.lds + RING_OFF + F.wave * 16384);
    const int gw = F.vcu * NWAVES + F.wave, NGW = F.G * NWAVES;
    constexpr int I_IN = (D / 64) * (NIN / 32), I_O = (D / 64) * (D / 32), I_1 = (D / 64) * (NFF2 / 32), I_2 = (DFF / 64) * (D / 32);
    constexpr int NITEMS = I_IN + I_O + I_1 + I_2;
    for (int it = gw; it < NITEMS; it += NGW) {
        int r = it;
        if (r < I_IN) { p0_transpose_item(KIN(9, const float*), D, NIN, ((bf16*)(F.ws + WS_WIN)), scr, r, F.lane); continue; } r -= I_IN;
        if (r < I_O) { p0_transpose_item(KIN(10, const float*), D, D, ((bf16*)(F.ws + WS_WO)), scr, r, F.lane); continue; } r -= I_O;
        if (r < I_1) { p0_transpose_item(KIN(18, const float*), D, NFF2, ((bf16*)(F.ws + WS_WF1)), scr, r, F.lane); continue; } r -= I_1;
        p0_transpose_item(KIN(21, const float*), DFF, D, ((bf16*)(F.ws + WS_WF2)), scr, r, F.lane);
    }
    for (int m = gw; m < MPAD; m += NGW) {
        if (m < MT) rms_row_to_bf16(F.lane, m < MP ? KIN(0, const float*) + (size_t)m * D : KIN(1, const float*) + (size_t)(m - MP) * D, KIN(7, const float*), ((bf16*)(F.ws + WS_XN)) + (size_t)m * D);
        else { zero_row_bf16(F.lane, ((bf16*)(F.ws + WS_XN)) + (size_t)m * D, D); zero_row_bf16(F.lane, ((bf16*)(F.ws + WS_MIX)) + (size_t)m * D, D); zero_row_bf16(F.lane, ((bf16*)(F.ws + WS_XN2)) + (size_t)m * D, D); zero_row_bf16(F.lane, ((bf16*)(F.ws + WS_ACT)) + (size_t)m * DFF, DFF); }
    }
}

struct EpiInProj {
    static constexpr bool PERM = true, AFTER_DRAIN = false;
    bf16* Z; float* out;
    __device__ __forceinline__ void operator()(const pg8::f32x4 (&acc)[2][2][4][2], const pg8::Unit& u, int wr, int wc, int fr, int fq) const {
        const int row0 = u.pm * 256 + wr * 64 + fr, col0 = u.pn * 256 + wc * 32 + 8 * fq;
        const float sc = (u.pn == 2 || u.pn == 3) ? RK_SCALE : ((u.pn == 8 || u.pn == 9) ? QC2 : 1.f);
        const bool kv = u.pn >= 10; const int kvcol = col0 - (u.pn < 12 ? CDK : CDV);
#pragma unroll
        for (int ai = 0; ai < 2; ++ai)
#pragma unroll
            for (int m = 0; m < 4; ++m) { const int row = row0 + ai * 128 + m * 16; bf16* rowp = Z + (size_t)row * NIN + col0;
                float* orow = nullptr;
                if (kv && row < MT) orow = (row < MP) ? F_out(u.pn < 12 ? O_KP : O_VP) + (size_t)row * 512 + kvcol : F_out(u.pn < 12 ? O_KS : O_VS) + (size_t)(row - MP) * 512 + kvcol;
#pragma unroll
                for (int bj = 0; bj < 2; ++bj) { const pg8::f32x4 a0 = acc[ai][bj][m][0], a1 = acc[ai][bj][m][1]; const pg8::f32x4 v0 = a0 * sc, v1 = a1 * sc;
                    pg8::u32x4 w; w.x = pg8::cvt_pk_bf16(v0[0], v0[1]); w.y = pg8::cvt_pk_bf16(v0[2], v0[3]); w.z = pg8::cvt_pk_bf16(v1[0], v1[1]); w.w = pg8::cvt_pk_bf16(v1[2], v1[3]);
                    *(pg8::u32x4*)(rowp + bj * 128) = w;
                    if (orow) { *(pg8::f32x4*)(orow + bj * 128) = a0; *(pg8::f32x4*)(orow + bj * 128 + 4) = a1; } } }
    }
    __device__ __forceinline__ float* F_out(size_t off) const { return out + off; }
};
struct EpiF32 {
    static constexpr bool PERM = true, AFTER_DRAIN = false;
    float* O; int ldc;
    __device__ __forceinline__ void operator()(const pg8::f32x4 (&acc)[2][2][4][2], const pg8::Unit& u, int wr, int wc, int fr, int fq) const {
        const int row0 = u.pm * 256 + wr * 64 + fr, col0 = u.pn * 256 + wc * 32 + 8 * fq;
#pragma unroll
        for (int ai = 0; ai < 2; ++ai)
#pragma unroll
            for (int m = 0; m < 4; ++m) { float* rowp = O + (size_t)(row0 + ai * 128 + m * 16) * ldc + col0;
#pragma unroll
                for (int bj = 0; bj < 2; ++bj) { *(pg8::f32x4*)(rowp + bj * 128) = acc[ai][bj][m][0]; *(pg8::f32x4*)(rowp + bj * 128 + 4) = acc[ai][bj][m][1]; } }
    }
};

__device__ __forceinline__ f32x4 mfma16(bf16x8 a, bf16x8 b, f32x4 c) { return __builtin_amdgcn_mfma_f32_16x16x32_bf16(a, b, c, 0, 0, 0); }
__device__ __forceinline__ bf16x8 lds_strided8(const LAS bf16* p, int ld) {
    bf16x8 r;
#pragma unroll
    for (int j = 0; j < 8; ++j) r[j] = (short)p[j * ld];
    return r;
}
constexpr int LDP = 132;
constexpr int LDA = 136;

template <bool SCALE> __device__ __forceinline__ void tile_to_lds(int tid, const bf16* src, int pitch, LAS bf16* dst, float sc0, float sc1) {
    const int r = tid >> 2, c0 = (tid & 3) * 32;
    const GAS v4u* s = (const GAS v4u*)(src + (size_t)r * pitch + c0);
    const float f = SCALE ? ex2(sc0 + (float)r * sc1) : 1.f;
#pragma unroll
    for (int i = 0; i < 4; ++i) { const v4u w = s[i]; u32x2 o0, o1;
        if (SCALE) { o0.x = pk2(bflo(w.x) * f, bfhi(w.x) * f); o0.y = pk2(bflo(w.y) * f, bfhi(w.y) * f); o1.x = pk2(bflo(w.z) * f, bfhi(w.z) * f); o1.y = pk2(bflo(w.w) * f, bfhi(w.w) * f); }
        else { o0.x = w.x; o0.y = w.y; o1.x = w.z; o1.y = w.w; }
        *(LAS u32x2*)(dst + r * LDP + c0 + i * 8) = o0; *(LAS u32x2*)(dst + r * LDP + c0 + i * 8 + 4) = o1; }
}

struct DecState { float m, l; f32x4 a; };
__device__ __forceinline__ void dec_update(DecState& s, const float (&sc)[4], const f32x4 (&v)[4]) {
    const float mn = fmaxf(fmaxf(fmaxf(sc[0], sc[1]), fmaxf(sc[2], sc[3])), s.m);
    const float f = ex2(s.m - mn);
    const float p0 = ex2(sc[0] - mn), p1 = ex2(sc[1] - mn), p2 = ex2(sc[2] - mn), p3 = ex2(sc[3] - mn);
    s.l = s.l * f + ((p0 + p1) + (p2 + p3));
    s.a = s.a * f + v[0] * p0 + v[1] * p1 + v[2] * p2 + v[3] * p3;
    s.m = mn;
}
__device__ __forceinline__ void decode_unit(Frame& F, int unit) {
    const int b = unit >> 4, pg = unit & 15, l = F.lane, w = F.wave;
    const int page = KIN(6, const int*)[b * 16 + pg];
    const float* kbase = KIN(3, const float*) + (size_t)page * 128 * 512;
    const float* vbase = KIN(4, const float*) + (size_t)page * 128 * 512;
    const int hA = l >> 5, hB = 2 + (l >> 5), mp = (l >> 4) & 1;
    const bf16* zq = ((bf16*)(F.ws + WS_Z)) + (size_t)(MP + b) * NIN + CDQ;
    const u32x2 qa = *(const GAS u32x2*)(zq + hA * 128 + mp * 64 + 4 * (l & 15)), qb = *(const GAS u32x2*)(zq + hB * 128 + mp * 64 + 4 * (l & 15));
    const f32x4 qA = {bflo(qa.x), bfhi(qa.x), bflo(qa.y), bfhi(qa.y)}, qB = {bflo(qb.x), bfhi(qb.x), bflo(qb.y), bfhi(qb.y)};
    const float slA = ex2(-2.f * (float)(hA + 1)) * LOG2E, slB = ex2(-2.f * (float)(hB + 1)) * LOG2E;
    DecState s0A{-1e30f, 0.f, {0.f, 0.f, 0.f, 0.f}}, s1A = s0A, s0B = s0A, s1B = s0A;
#pragma unroll 1
    for (int kk = 0; kk < 16; kk += 4) {
        f32x4 kA[4], kB[4], vA[4], vB[4];
#pragma unroll
        for (int i = 0; i < 4; ++i) { const size_t ro = (size_t)(16 * w + kk + i) * 512 + 4 * l;
            kA[i] = *(const GAS f32x4*)(kbase + ro); kB[i] = *(const GAS f32x4*)(kbase + ro + 256);
            vA[i] = *(const GAS f32x4*)(vbase + ro); vB[i] = *(const GAS f32x4*)(vbase + ro + 256); }
        float c0A[4], c1A[4], c0B[4], c1B[4];
#pragma unroll
        for (int i = 0; i < 4; ++i) {
            const float dist = (float)(pg * 128 + 16 * w + kk + i - 2048);
            float sa = (qA.x * kA[i].x + qA.y * kA[i].y) + (qA.z * kA[i].z + qA.w * kA[i].w);
            float sb = (qB.x * kB[i].x + qB.y * kB[i].y) + (qB.z * kB[i].z + qB.w * kB[i].w);
            sa = sum16(sa) + slA * dist; sb = sum16(sb) + slB * dist;
            const float oa = __shfl_xor(sa, 16), ob = __shfl_xor(sb, 16);
            c0A[i] = mp ? oa : sa; c1A[i] = mp ? sa : oa; c0B[i] = mp ? ob : sb; c1B[i] = mp ? sb : ob;
        }
        dec_update(s0A, c0A, vA); dec_update(s1A, c1A, vA); dec_update(s0B, c0B, vB); dec_update(s1B, c1B, vB);
    }
    LAS float* P = (LAS float*)(F.lds + RING_OFF);
    {   const int e4 = 4 * (l & 31);
        LAS float* pa0 = P + ((w * 8 + hA * 2 + 0) * 132), *pa1 = P + ((w * 8 + hA * 2 + 1) * 132), *pb0 = P + ((w * 8 + hB * 2 + 0) * 132), *pb1 = P + ((w * 8 + hB * 2 + 1) * 132);
        *(LAS f32x4*)(pa0 + 4 + e4) = s0A.a; *(LAS f32x4*)(pa1 + 4 + e4) = s1A.a; *(LAS f32x4*)(pb0 + 4 + e4) = s0B.a; *(LAS f32x4*)(pb1 + 4 + e4) = s1B.a;
        if ((l & 31) == 0) { pa0[0] = s0A.m; pa0[1] = s0A.l; pa1[0] = s1A.m; pa1[1] = s1A.l; pb0[0] = s0B.m; pb0[1] = s0B.l; pb1[0] = s1B.m; pb1[1] = s1B.l; } }
    WG_SYNC();
    {   float Mx = -1e30f;
#pragma unroll
        for (int j = 0; j < 8; ++j) Mx = fmaxf(Mx, P[(j * 8 + w) * 132]);
        float Ls = 0.f; f32x4 A = {0.f, 0.f, 0.f, 0.f}; const int e4 = 4 * (l & 31);
#pragma unroll
        for (int j = 0; j < 8; ++j) { const LAS float* pj = P + (j * 8 + w) * 132; const float f = ex2(pj[0] - Mx); Ls += pj[1] * f; A = A + *(const LAS f32x4*)(pj + 4 + e4) * f; }
        float* dst = ((float*)(F.ws + WS_PART)) + ((size_t)unit * 8 + w) * 132;
        if (l < 32) *(GAS f32x4*)(dst + 4 + e4) = A;
        if (l == 0) { dst[0] = Mx; dst[1] = Ls; } }
    WG_SYNC();
}
__device__ __forceinline__ void ret_sample_item(Frame& F, int bh) {
    const int b = bh >> 2, h = bh & 3, l = F.lane, w = F.wave;
    const float gamma = 1.f - ex2(-5.f - (float)h);
    const bf16* z = ((bf16*)(F.ws + WS_Z)) + (size_t)(MP + b) * NIN;
    const unsigned vw = *(const GAS unsigned*)(z + CV + h * 128 + 2 * l);
    const float v0 = bflo(vw), v1 = bfhi(vw);
    float o0 = 0.f, o1 = 0.f;
#pragma unroll 4
    for (int i = 0; i < 16; ++i) { const int d = 16 * w + i;
        const float kd = bf2f(z[CK + h * 128 + d]), qd = bf2f(z[CQ + h * 128 + d]);
        const size_t idx = ((size_t)bh * 128 + d) * 128 + 2 * l;
        const f32x2 s = *(const GAS f32x2*)(KIN(2, const float*) + idx);
        f32x2 sn; sn.x = gamma * s.x + kd * v0; sn.y = gamma * s.y + kd * v1;
        *(GAS f32x2*)(F.out + O_RSS + idx) = sn; o0 += qd * sn.x; o1 += qd * sn.y; }
    LAS float* red = (LAS float*)(F.lds + RING_OFF);
    red[w * 128 + 2 * l] = o0; red[w * 128 + 2 * l + 1] = o1;
    WG_SYNC();
    if (w == 0) { float a0 = 0.f, a1 = 0.f;
#pragma unroll
        for (int j = 0; j < 8; ++j) { a0 += red[j * 128 + 2 * l]; a1 += red[j * 128 + 2 * l + 1]; }
        const float rs = rsqrtf(wave_sum(a0 * a0 + a1 * a1) * (1.f / 128.f) + EPS);
        const unsigned gw = *(const GAS unsigned*)(z + CG + h * 128 + 2 * l);
        *(GAS unsigned*)(((bf16*)(F.ws + WS_MIX)) + (size_t)(MP + b) * D + h * 128 + 2 * l) = pk2(a0 * rs * silu_f(bflo(gw)), a1 * rs * silu_f(bfhi(gw))); }
    WG_SYNC();
}
__device__ __forceinline__ void ret_kv_unit(Frame& F, int unit) {
    const int bh = unit >> 4, c = unit & 15, b = bh >> 2, h = bh & 3, l = F.lane, w = F.wave, g = l >> 4, lc = l & 15;
    const float lg = log2f(1.f - ex2(-5.f - (float)h));
    const bf16* zrow = ((bf16*)(F.ws + WS_Z)) + (size_t)(b * T + c * 128) * NIN;
    LAS bf16* Ks = (LAS bf16*)(F.lds + RING_OFF); LAS bf16* Vs = Ks + 128 * LDP;
    tile_to_lds<true>(F.tid, zrow + CK + h * 128, NIN, Ks, 127.f * lg, -lg);
    tile_to_lds<false>(F.tid, zrow + CV + h * 128, NIN, Vs, 0.f, 0.f);
    WG_SYNC();
    bf16x8 Af[4];
#pragma unroll
    for (int js = 0; js < 4; ++js) Af[js] = lds_strided8(Ks + (32 * js + 8 * g) * LDP + 16 * w + lc, LDP);
    float* dst = ((float*)(F.ws + WS_KV)) + (size_t)unit * 16384;
#pragma unroll 2
    for (int et = 0; et < 8; ++et) { f32x4 acc = {0.f, 0.f, 0.f, 0.f};
#pragma unroll
        for (int js = 0; js < 4; ++js) acc = mfma16(Af[js], lds_strided8(Vs + (32 * js + 8 * g) * LDP + 16 * et + lc, LDP), acc);
#pragma unroll
        for (int r = 0; r < 4; ++r) dst[(16 * w + 4 * g + r) * 128 + 16 * et + lc] = acc[r]; }
    WG_SYNC();
}

__device__ __forceinline__ void ret_out_unit(Frame& F, int unit) {
    const int bh = unit >> 4, c = unit & 15, b = bh >> 2, h = bh & 3, l = F.lane, w = F.wave, g = l >> 4, lc = l & 15;
    const float lg = log2f(1.f - ex2(-5.f - (float)h));
    const float G128 = ex2(128.f * lg);
    const size_t tok0 = (size_t)b * T + c * 128;
    const bf16* zrow = ((bf16*)(F.ws + WS_Z)) + tok0 * NIN;
    LAS bf16* Vs = (LAS bf16*)(F.lds + RING_OFF); LAS bf16* Ss = Vs + 128 * LDP; LAS bf16* Aw = Ss + 128 * LDP + w * 16 * LDA;
    {
        const float* kvb = ((float*)(F.ws + WS_KV)) + (size_t)bh * 16 * 16384;
#pragma unroll 2
        for (int i = 0; i < 8; ++i) { const int idx = F.tid * 4 + 2048 * i; f32x4 s = {0.f, 0.f, 0.f, 0.f};
            for (int j = 0; j < c; ++j) s = s * G128 + *(const GAS f32x4*)(kvb + (size_t)j * 16384 + idx);
            u32x2 o; o.x = pk2(s.x, s.y); o.y = pk2(s.z, s.w);
            *(LAS u32x2*)(Ss + (idx >> 7) * LDP + (idx & 127)) = o;
            if (c == 15) *(GAS f32x4*)(F.out + O_RSP + (size_t)bh * 16384 + idx) = s * G128 + *(const GAS f32x4*)(kvb + (size_t)15 * 16384 + idx); } }
    tile_to_lds<false>(F.tid, zrow + CV + h * 128, NIN, Vs, 0.f, 0.f);
    WG_SYNC();
    bf16x8 Aq[4];
#pragma unroll
    for (int ks = 0; ks < 4; ++ks) Aq[ks] = *(const GAS bf16x8*)(zrow + (size_t)(16 * w + lc) * NIN + CQ + h * 128 + 32 * ks + 8 * g);
#pragma unroll 1
    for (int jt = 0; jt < 8; ++jt) { f32x4 acc = {0.f, 0.f, 0.f, 0.f};
        if (jt <= w) {
#pragma unroll
            for (int ks = 0; ks < 4; ++ks) acc = mfma16(Aq[ks], *(const GAS bf16x8*)(zrow + (size_t)(16 * jt + lc) * NIN + CK + h * 128 + 32 * ks + 8 * g), acc);
#pragma unroll
            for (int r = 0; r < 4; ++r) { const int dij = (16 * w + 4 * g + r) - (16 * jt + lc); acc[r] = dij >= 0 ? acc[r] * ex2((float)dij * lg) : 0.f; } }
#pragma unroll
        for (int r = 0; r < 4; ++r) Aw[(4 * g + r) * LDA + 16 * jt + lc] = (bf16)f2bf(acc[r]); }
    LDS_WAIT(); asm volatile("" ::: "memory");
    f32x4 o[8]; float ss[4] = {0.f, 0.f, 0.f, 0.f};
    float qdec[4];
#pragma unroll
    for (int r = 0; r < 4; ++r) qdec[r] = ex2((float)(16 * w + 4 * g + r + 1) * lg);
#pragma unroll 2
    for (int et = 0; et < 8; ++et) { f32x4 a1 = {0.f, 0.f, 0.f, 0.f}, a2 = {0.f, 0.f, 0.f, 0.f};
#pragma unroll
        for (int js = 0; js < 4; ++js) if (32 * js <= 16 * w + 15)
            a1 = mfma16(*(const LAS bf16x8*)(Aw + lc * LDA + 32 * js + 8 * g), lds_strided8(Vs + (32 * js + 8 * g) * LDP + 16 * et + lc, LDP), a1);
#pragma unroll
        for (int ds = 0; ds < 4; ++ds) a2 = mfma16(Aq[ds], lds_strided8(Ss + (32 * ds + 8 * g) * LDP + 16 * et + lc, LDP), a2);
#pragma unroll
        for (int r = 0; r < 4; ++r) { const float v = a1[r] + qdec[r] * a2[r]; o[et][r] = v; ss[r] += v * v; } }
#pragma unroll
    for (int r = 0; r < 4; ++r) ss[r] = rsqrtf(sum16(ss[r]) * (1.f / 128.f) + EPS);
#pragma unroll
    for (int et = 0; et < 8; ++et)
#pragma unroll
        for (int r = 0; r < 4; ++r) { const size_t row = tok0 + 16 * w + 4 * g + r; const int e = 16 * et + lc;
            const float gt = bf2f(((bf16*)(F.ws + WS_Z))[row * NIN + CG + h * 128 + e]);
            ((bf16*)(F.ws + WS_MIX))[row * D + h * 128 + e] = (bf16)f2bf(o[et][r] * ss[r] * silu_f(gt)); }
    WG_SYNC();
}
__device__ __forceinline__ void diff_combine_row(Frame& F, int row, float lam) {
    const int l = F.lane, hh = l >> 4, e8 = 8 * (l & 15);
    const v4u a = *(const GAS v4u*)(((bf16*)(F.ws + WS_ATT)) + (size_t)row * 1024 + hh * 256 + e8), c = *(const GAS v4u*)(((bf16*)(F.ws + WS_ATT)) + (size_t)row * 1024 + hh * 256 + 128 + e8);
    float d[8];
    d[0] = bflo(a.x) - lam * bflo(c.x); d[1] = bfhi(a.x) - lam * bfhi(c.x); d[2] = bflo(a.y) - lam * bflo(c.y); d[3] = bfhi(a.y) - lam * bfhi(c.y);
    d[4] = bflo(a.z) - lam * bflo(c.z); d[5] = bfhi(a.z) - lam * bfhi(c.z); d[6] = bflo(a.w) - lam * bflo(c.w); d[7] = bfhi(a.w) - lam * bfhi(c.w);
    float s = 0.f;
#pragma unroll
    for (int i = 0; i < 8; ++i) s += d[i] * d[i];
    const float rs = rsqrtf(sum16(s) * (1.f / 128.f) + EPS) * 0.8f;
    const f32x4 g0 = *(const GAS f32x4*)(KIN(15, const float*) + e8), g1 = *(const GAS f32x4*)(KIN(15, const float*) + e8 + 4);
    v4u o; o.x = pk2(d[0] * rs * g0.x, d[1] * rs * g0.y); o.y = pk2(d[2] * rs * g0.z, d[3] * rs * g0.w); o.z = pk2(d[4] * rs * g1.x, d[5] * rs * g1.y); o.w = pk2(d[6] * rs * g1.z, d[7] * rs * g1.w);
    *(GAS v4u*)(((bf16*)(F.ws + WS_MIX)) + (size_t)row * D + 512 + hh * 128 + e8) = o;
}
__device__ __forceinline__ void decode_combine_item(Frame& F, int bh, float lam) {
    const int b = bh >> 2, h = bh & 3, l = F.lane;
    const bf16* z = ((bf16*)(F.ws + WS_Z)) + (size_t)(MP + b) * NIN;
    const unsigned vw = *(const GAS unsigned*)(z + CDV + h * 128 + 2 * l);
    const float vn0 = bflo(vw), vn1 = bfhi(vw);
    float O[2][2];
#pragma unroll
    for (int mm = 0; mm < 2; ++mm) {
        const float sn = wave_sum(bf2f(z[CDQ + h * 128 + mm * 64 + l]) * bf2f(z[CDK + h * 128 + mm * 64 + l]));
        const float* pb = ((float*)(F.ws + WS_PART)) + ((size_t)(b * 16) * 8 + h * 2 + mm) * 132;
        float Mx = sn;
#pragma unroll
        for (int pg = 0; pg < 16; ++pg) Mx = fmaxf(Mx, pb[(size_t)pg * 8 * 132]);
        const float fn = ex2(sn - Mx); float Ls = fn, a0 = fn * vn0, a1 = fn * vn1;
#pragma unroll
        for (int pg = 0; pg < 16; ++pg) { const float* pp = pb + (size_t)pg * 8 * 132; const float f = ex2(pp[0] - Mx); Ls += pp[1] * f;
            const f32x2 av = *(const GAS f32x2*)(pp + 4 + 2 * l); a0 += av.x * f; a1 += av.y * f; }
        const float inv = 1.f / Ls; O[mm][0] = a0 * inv; O[mm][1] = a1 * inv; }
    const float d0 = O[0][0] - lam * O[1][0], d1 = O[0][1] - lam * O[1][1];
    const float rs = rsqrtf(wave_sum(d0 * d0 + d1 * d1) * (1.f / 128.f) + EPS) * 0.8f;
    *(GAS unsigned*)(((bf16*)(F.ws + WS_MIX)) + (size_t)(MP + b) * D + 512 + h * 128 + 2 * l) = pk2(d0 * rs * KIN(15, const float*)[2 * l], d1 * rs * KIN(15, const float*)[2 * l + 1]);
}

__device__ __forceinline__ void post1_row(Frame& F, int row) {
    const int l = F.lane;
    const GAS f32x4* tr = (const GAS f32x4*)(((float*)(F.ws + WS_T1)) + (size_t)row * D) + l;
    const GAS f32x4* xr = (const GAS f32x4*)(row < MP ? KIN(0, const float*) + (size_t)row * D : KIN(1, const float*) + (size_t)(row - MP) * D) + l;
    f32x4 t[4], x[4]; float s = 0.f;
#pragma unroll
    for (int j = 0; j < 4; ++j) { t[j] = tr[64 * j]; x[j] = xr[64 * j]; s += (t[j].x * t[j].x + t[j].y * t[j].y) + (t[j].z * t[j].z + t[j].w * t[j].w); }
    const float rs = rsqrtf(wave_sum(s) * (1.f / D) + EPS); float s2 = 0.f;
#pragma unroll
    for (int j = 0; j < 4; ++j) { const f32x4 gg = ((const GAS f32x4*)KIN(8, const float*))[l + 64 * j]; x[j] = x[j] + t[j] * rs * gg;
        ((GAS f32x4*)(((float*)(F.ws + WS_X1)) + (size_t)row * D))[l + 64 * j] = x[j]; s2 += (x[j].x * x[j].x + x[j].y * x[j].y) + (x[j].z * x[j].z + x[j].w * x[j].w); }
    const float rs2 = rsqrtf(wave_sum(s2) * (1.f / D) + EPS);
    GAS unsigned long long* o8 = (GAS unsigned long long*)(((bf16*)(F.ws + WS_XN2)) + (size_t)row * D) + l;
#pragma unroll
    for (int j = 0; j < 4; ++j) { const f32x4 gg = ((const GAS f32x4*)KIN(16, const float*))[l + 64 * j];
        o8[64 * j] = (unsigned long long)pk2(x[j].x * rs2 * gg.x, x[j].y * rs2 * gg.y) | ((unsigned long long)pk2(x[j].z * rs2 * gg.z, x[j].w * rs2 * gg.w) << 32); }
}
__device__ __forceinline__ void final_row(Frame& F, int row) {
    const int l = F.lane;
    const GAS f32x4* tr = (const GAS f32x4*)(((float*)(F.ws + WS_T2)) + (size_t)row * D) + l;
    const GAS f32x4* xr = (const GAS f32x4*)(((float*)(F.ws + WS_X1)) + (size_t)row * D) + l;
    f32x4 t[4]; float s = 0.f;
#pragma unroll
    for (int j = 0; j < 4; ++j) { t[j] = tr[64 * j]; s += (t[j].x * t[j].x + t[j].y * t[j].y) + (t[j].z * t[j].z + t[j].w * t[j].w); }
    const float rs = rsqrtf(wave_sum(s) * (1.f / D) + EPS);
    GAS f32x4* yo = (GAS f32x4*)(row < MP ? F.out + O_Y + (size_t)row * D : F.out + O_YS + (size_t)(row - MP) * D) + l;
#pragma unroll
    for (int j = 0; j < 4; ++j) { const f32x4 gg = ((const GAS f32x4*)KIN(17, const float*))[l + 64 * j]; yo[64 * j] = xr[64 * j] + t[j] * rs * gg; }
}
__device__ __forceinline__ void unpack8(const v4u w, f32x4& lo, f32x4& hi) { lo = (f32x4){bflo(w.x), bfhi(w.x), bflo(w.y), bfhi(w.y)}; hi = (f32x4){bflo(w.z), bfhi(w.z), bflo(w.w), bfhi(w.w)}; }
__device__ __forceinline__ f32x4 gelu4(const f32x4 c) { return (f32x4){gelu_tanh_f(c.x), gelu_tanh_f(c.y), gelu_tanh_f(c.z), gelu_tanh_f(c.w)}; }
__device__ __forceinline__ void act_row(Frame& F, int row) {
    const int l = F.lane;
    const bool smp = row >= MP; const int t = smp ? 0 : (row & (T - 1)), bi = smp ? row - MP : (row >> 11);
    const bf16* zr = ((bf16*)(F.ws + WS_ZF)) + (size_t)row * NFF2;
#pragma unroll 1
    for (int ch = l; ch < DFF / 8; ch += 64) { const int f = 8 * ch;
        f32x4 g0a, g0b, ua, ub, g1a, g1b, g2a, g2b;
        unpack8(*(const GAS v4u*)(zr + f), g0a, g0b); unpack8(*(const GAS v4u*)(zr + DFF + f), ua, ub);
        if (smp) { const float* sc = KIN(5, const float*) + (size_t)bi * 2 * DFF + f;
            g2a = *(const GAS f32x4*)(sc); g2b = *(const GAS f32x4*)(sc + 4); g1a = *(const GAS f32x4*)(sc + DFF); g1b = *(const GAS f32x4*)(sc + DFF + 4);
            float* co = F.out + O_CS + (size_t)bi * 2 * DFF + f;
            *(GAS f32x4*)(co) = g1a; *(GAS f32x4*)(co + 4) = g1b; *(GAS f32x4*)(co + DFF) = g0a; *(GAS f32x4*)(co + DFF + 4) = g0b;
        } else {
            v4u p1 = {0u, 0u, 0u, 0u}, p2 = {0u, 0u, 0u, 0u};
            if (t >= 1) p1 = *(const GAS v4u*)(zr - NFF2 + f);
            if (t >= 2) p2 = *(const GAS v4u*)(zr - 2 * NFF2 + f);
            unpack8(p1, g1a, g1b); unpack8(p2, g2a, g2b);
            if (t >= T - 2) { float* co = F.out + O_CP + ((size_t)bi * 2 + (t - (T - 2))) * DFF + f; *(GAS f32x4*)(co) = g0a; *(GAS f32x4*)(co + 4) = g0b; }
        }
        const f32x4 w0a = *(const GAS f32x4*)(KIN(19, const float*) + f), w0b = *(const GAS f32x4*)(KIN(19, const float*) + f + 4), w1a = *(const GAS f32x4*)(KIN(19, const float*) + DFF + f), w1b = *(const GAS f32x4*)(KIN(19, const float*) + DFF + f + 4);
        const f32x4 w2a = *(const GAS f32x4*)(KIN(19, const float*) + 2 * DFF + f), w2b = *(const GAS f32x4*)(KIN(19, const float*) + 2 * DFF + f + 4), ba = *(const GAS f32x4*)(KIN(20, const float*) + f), bb = *(const GAS f32x4*)(KIN(20, const float*) + f + 4);
        const f32x4 aa = gelu4(w0a * g2a + w1a * g1a + w2a * g0a + ba) * ua, ab = gelu4(w0b * g2b + w1b * g1b + w2b * g0b + bb) * ub;
        v4u o; o.x = pk2(aa.x, aa.y); o.y = pk2(aa.z, aa.w); o.z = pk2(ab.x, ab.y); o.w = pk2(ab.z, ab.w);
        *(GAS v4u*)(((bf16*)(F.ws + WS_ACT)) + (size_t)row * DFF + f) = o;
    }
}
struct Args { const void* in[22]; float* out; unsigned char* ws; int ph_lo, ph_hi, li, pad; };
static_assert(sizeof(Args) == 22 * 8 + 8 + 8 + 16, "Args has no holes");
constexpr int N_PHASES = 10;

__global__ void __launch_bounds__(NWAVES * 64, 2) mk_fwd(Args args) {
    extern __shared__ __attribute__((aligned(16))) unsigned char lds[];
    Frame F;
    F.lds = (LAS unsigned char*)lds;
    F.MISC = (volatile LAS unsigned*)(F.lds + MISC_OFF);
    F.tid = threadIdx.x; F.lane = F.tid & 63; F.wave = __builtin_amdgcn_readfirstlane(F.tid >> 6);
    F.G = gridDim.x; { const int bx = blockIdx.x; F.vcu = (F.G % 8 == 0) ? (bx % 8) * (F.G / 8) + bx / 8 : bx; }
    F.ws = args.ws; F.out = args.out;
    F.ctl = (gu32*)(F.ws + WS_CTL);
    for (int u = F.tid; u < (LDS_BYTES - LDSCTL_OFF) / 4; u += NWAVES * 64) ((LAS unsigned*)(F.lds + LDSCTL_OFF))[u] = 0u;
    __syncthreads();
    const int lo = args.ph_lo, hi = args.ph_hi;
    const bool one_phase = (hi - lo) == 1;
    XcdBarrier bar; bar.bar = (unsigned*)(F.ctl + CW_BAR) + args.li * XCD_BAR_WORDS; bar.x = 0; bar.st = nullptr;
    if (!one_phase) bar = xcd_barrier_post((unsigned*)(F.ctl + CW_BAR) + args.li * XCD_BAR_WORDS, F.MISC + 8);
#define IN(k) (lo <= (k) && (k) < hi)
#define SEAM(k) do { if (IN(k) && IN((k) + 1)) xcd_barrier(bar); } while (0)
    const int gw = F.vcu * NWAVES + F.wave, NGW = F.G * NWAVES;

    if (IN(0)) { p0_prologue(F); }
    SEAM(0);
    if (IN(1)) {
        pg8::Gemm g{((bf16*)(F.ws + WS_XN)), ((bf16*)(F.ws + WS_WIN)), MPAD, NIN, D}; pg8::StaticOrder S; S.init(MPAD, NIN, F.G, (int)blockIdx.x);
        EpiInProj E{((bf16*)(F.ws + WS_Z)), F.out};
        pg8::gemm_phase<EpiInProj, pg8::StaticOrder, PG8_ALIGN, PG8_SP2>(F.lds + RING_OFF, g, S, E);
    }
    SEAM(1);
    if (IN(2)) {
        for (int u = F.vcu; u < DB * 16; u += F.G) decode_unit(F, u);
        for (int u = F.vcu; u < DB * 4; u += F.G) ret_sample_item(F, u);
        for (int u = F.vcu; u < 512; u += F.G) ret_kv_unit(F, u);
        for (int u = F.vcu; u < 1024; u += F.G) {
            const int i = u >> 8, v = u & 255, combo = v >> 1, p = v & 1;
            const int b = combo >> 4, h = (combo >> 2) & 3, m = (combo >> 1) & 1, vh = combo & 1;
            const int qb = p == 0 ? (i == 0 ? 0 : i == 1 ? 7 : i == 2 ? 1 : 6) : (i == 0 ? 2 : i == 1 ? 5 : i == 2 ? 3 : 4);
            const float sl2 = ex2(-2.f * (float)(h + 1)) * LOG2E;
            attn_body::attn_unit<8>(b, qb, (const attn_body::bf16*)((bf16*)(F.ws + WS_Z)) + CDQ + h * 128 + m * 64, (const attn_body::bf16*)((bf16*)(F.ws + WS_Z)) + CDK + h * 128 + m * 64, (const attn_body::bf16*)((bf16*)(F.ws + WS_Z)) + CDV + h * 128 + vh * 64,
                                    (attn_body::bf16*)((bf16*)(F.ws + WS_ATT)) + h * 256 + m * 128 + vh * 64, sl2, (char*)lds + RING_OFF);
        }
    }
    SEAM(2);
    if (IN(3)) {
        const float lam = lambda_of(F);
        for (int u = F.vcu; u < 512; u += F.G) ret_out_unit(F, u);
        for (int r = gw; r < MP; r += NGW) diff_combine_row(F, r, lam);
        for (int u = gw; u < DB * 4; u += NGW) decode_combine_item(F, u, lam);
    }
    SEAM(3);
    if (IN(4)) {
        pg8::Gemm g{((bf16*)(F.ws + WS_MIX)), ((bf16*)(F.ws + WS_WO)), MPAD, D, D}; pg8::StaticOrder S; S.init(MPAD, D, F.G, (int)blockIdx.x);
        EpiF32 E{((float*)(F.ws + WS_T1)), D};
        pg8::gemm_phase<EpiF32, pg8::StaticOrder, PG8_ALIGN, PG8_SP2>(F.lds + RING_OFF, g, S, E);
    }
    SEAM(4);
    if (IN(5)) { for (int r = gw; r < MT; r += NGW) post1_row(F, r); }
    SEAM(5);
    if (IN(6)) {
        pg8::Gemm g{((bf16*)(F.ws + WS_XN2)), ((bf16*)(F.ws + WS_WF1)), MPAD, NFF2, D}; pg8::StaticOrder S; S.init(MPAD, NFF2, F.G, (int)blockIdx.x);
        pg8::EpiBf16<0> E{((bf16*)(F.ws + WS_ZF)), NFF2, nullptr, 0, 0, 1.f};
        pg8::gemm_phase<pg8::EpiBf16<0>, pg8::StaticOrder, PG8_ALIGN, PG8_SP2>(F.lds + RING_OFF, g, S, E);
    }
    SEAM(6);
    if (IN(7)) { for (int r = gw; r < MT; r += NGW) act_row(F, r); }
    SEAM(7);
    if (IN(8)) {
        pg8::Gemm g{((bf16*)(F.ws + WS_ACT)), ((bf16*)(F.ws + WS_WF2)), MPAD, D, DFF}; pg8::StaticOrder S; S.init(MPAD, D, F.G, (int)blockIdx.x);
        EpiF32 E{((float*)(F.ws + WS_T2)), D};
        pg8::gemm_phase<EpiF32, pg8::StaticOrder, PG8_ALIGN, PG8_SP2>(F.lds + RING_OFF, g, S, E);
    }
    SEAM(8);
    if (IN(9)) { for (int r = gw; r < MT; r += NGW) final_row(F, r); }
#undef IN
#undef SEAM
}

static int mk_grid = 0;
static bool mk_setup() {
    if (mk_grid != 0) return mk_grid > 0;
    int dev = 0, cus = 0, per_cu = 0;
    if (hipGetDevice(&dev) != hipSuccess || hipDeviceGetAttribute(&cus, hipDeviceAttributeMultiprocessorCount, dev) != hipSuccess) { fprintf(stderr, "kernel_launch: hipGetDevice / hipDeviceGetAttribute failed\n"); mk_grid = -1; return false; }
    if (hipFuncSetAttribute((const void*)mk_fwd, hipFuncAttributeMaxDynamicSharedMemorySize, LDS_BYTES) != hipSuccess) { fprintf(stderr, "kernel_launch: hipFuncSetAttribute failed\n"); mk_grid = -1; return false; }
    if (hipOccupancyMaxActiveBlocksPerMultiprocessor(&per_cu, (const void*)mk_fwd, NWAVES * 64, LDS_BYTES) != hipSuccess || per_cu < 1)
        fprintf(stderr, "kernel_launch: note: the occupancy query reports %d workgroups per CU\n", per_cu);
    (void)hipGetLastError();
    mk_grid = cus;
    return true;
}
static void mk_run(void* const* d_in, float* out, unsigned char* ws, hipStream_t stream, const int* cuts, int ncuts) {
    if (!mk_setup()) return;
    (void)hipMemsetAsync(ws + WS_CTL, 0, CTL_ZERO_BYTES, stream);
    Args a{};
    for (int i = 0; i < 22; ++i) a.in[i] = d_in[i];
    a.out = out; a.ws = ws;
    for (int li = 0; li < ncuts; ++li) {
        a.ph_lo = cuts[li]; a.ph_hi = cuts[li + 1]; a.li = li;
        hipLaunchKernelGGL(mk_fwd, dim3(mk_grid), dim3(NWAVES * 64), LDS_BYTES, stream, a);
        const hipError_t le = hipPeekAtLastError();
        if (le != hipSuccess) { fprintf(stderr, "kernel_launch: launch %d failed: %s\n", li, hipGetErrorName(le)); break; }
    }
}
extern "C" void kernel_launch(void* const* d_in, const int* in_sizes, int n_in, void* d_out, int out_size, void* d_ws, size_t ws_size, hipStream_t stream) {
    if (n_in != 22 || out_size != (int)O_END || ws_size < WS_END) { fprintf(stderr, "kernel_launch: unexpected sizes n_in %d out %d ws %zu\n", n_in, out_size, ws_size); return; }
    static const int cuts[] = {0, N_PHASES};
    mk_run(d_in, (float*)d_out, (unsigned char*)d_ws, stream, cuts, 1);
}
```
